# Optimizing an MI355X kernel written in HIP

```python
import math
import jax, jax.numpy as jnp
from jax import lax
import numpy as np

D_MODEL = 2048
BATCH = 4
SEQ = 2048
DEPTH = 1
DEC_BATCH = 128
DEC_SEQ = 1
PAST_LEN = 16384
PAGE_SIZE = 128

D_MIX = D_MODEL
RG_WIDTH = D_MIX // 2
RG_BLOCKS = 8
RG_BLOCK = RG_WIDTH // RG_BLOCKS
CONV_W = 4
RG_C = 8.0
ML_HEADS = 4
ML_WIDTH = D_MIX - RG_WIDTH
ML_DV = ML_WIDTH // ML_HEADS
ML_DK = ML_DV // 2
ML_CHUNK = 64
N_MEM = 256
XA_HEADS = 4
XA_DH = D_MODEL // XA_HEADS
D_FF = -(-8 * D_MODEL // (3 * 256)) * 256
EPS = 1e-6
NEG = -1e30

OFF_RGX = 0
OFF_RGG = OFF_RGX + RG_WIDTH
OFF_Q = OFF_RGG + RG_WIDTH
OFF_K = OFF_Q + ML_HEADS * ML_DK
OFF_V = OFF_K + ML_HEADS * ML_DK
OFF_O = OFF_V + ML_WIDTH
OFF_I = OFF_O + ML_WIDTH
OFF_F = OFF_I + ML_HEADS
IN_W = OFF_F + ML_HEADS

kernel_name = "hymba_rglru_mlstm_memxattn_decode_step"


def rmsnorm(x, g):
    xf = x.astype(jnp.float32)
    y = xf * lax.rsqrt(jnp.mean(xf * xf, axis=-1, keepdims=True) + EPS)
    return (y * g.astype(jnp.float32)).astype(x.dtype)


def causal_conv(x, buf, w, b):
    L = x.shape[1]
    xp = jnp.concatenate([buf.astype(x.dtype), x], axis=1)
    y = b + sum(xp[:, j:j + L] * w[j] for j in range(CONV_W))
    return y, xp[:, L:]


def block_diag(x, w, b):
    B, L, _ = x.shape
    xb = x.reshape(B, L, RG_BLOCKS, RG_BLOCK)
    return jnp.einsum('blnc,ncd->blnd', xb, w).reshape(B, L, RG_WIDTH) + b


def rglru(xr, r, i, lam, h0):
    log_a = -RG_C * r * jax.nn.softplus(-lam)
    a = jnp.exp(log_a)
    mult = jnp.sqrt(jnp.maximum(1.0 - jnp.exp(2.0 * log_a), 0.0))
    bx = mult * (i * xr)
    bx = bx.at[:, 0].add(a[:, 0] * h0)

    def comb(c1, c2):
        a1, b1 = c1
        a2, b2 = c2
        return a1 * a2, a2 * b1 + b2

    _, h = lax.associative_scan(comb, (a, bx), axis=1)
    return h, h[:, -1]


def mlstm(q, k, v, logi, logf, C0, n0, m0):
    B, L = q.shape[0], q.shape[1]
    cs = min(ML_CHUNK, L)
    pad = (-L) % cs
    nc = (L + pad) // cs

    def prep(t, fill):
        t = jnp.moveaxis(t.astype(jnp.float32), 2, 1)
        widths = [(0, 0), (0, 0), (0, pad)] + [(0, 0)] * (t.ndim - 3)
        t = jnp.pad(t, widths, constant_values=fill)
        t = t.reshape(t.shape[:2] + (nc, cs) + t.shape[3:])
        return jnp.moveaxis(t, 2, 0)

    qs, ks, vs = prep(q, 0.0), prep(k, 0.0), prep(v, 0.0)
    lis, lfs = prep(logi, NEG), prep(logf, 0.0)
    causal = jnp.tril(jnp.ones((cs, cs), dtype=bool))

    def step(carry, inp):
        C, n, m = carry
        qc, kc, vc, li, lf = inp
        bcum = jnp.cumsum(lf, axis=-1)
        logD = bcum[..., :, None] - bcum[..., None, :] + li[..., None, :]
        logD = jnp.where(causal, logD, NEG)
        inter = bcum + m[..., None]
        m_t = jnp.maximum(inter, jnp.max(logD, axis=-1))
        D = jnp.exp(logD - m_t[..., None])
        sc = jnp.exp(inter - m_t)
        qk = jnp.einsum('bhtd,bhsd->bhts', qc, kc) * D
        num = sc[..., None] * jnp.einsum('bhtd,bhdv->bhtv', qc, C) + jnp.einsum('bhts,bhsv->bhtv', qk, vc)
        den = sc * jnp.einsum('bhtd,bhd->bht', qc, n) + jnp.sum(qk, axis=-1)
        den = jnp.maximum(jnp.abs(den), jnp.exp(-m_t))
        h = num / den[..., None]
        m_new = m_t[..., -1]
        w_end = jnp.exp(bcum[..., -1:] - bcum + li - m_new[..., None])
        dec = jnp.exp(bcum[..., -1] + m - m_new)
        C_new = dec[..., None, None] * C + jnp.einsum('bhs,bhsd,bhsv->bhdv', w_end, kc, vc)
        n_new = dec[..., None] * n + jnp.einsum('bhs,bhsd->bhd', w_end, kc)
        return (C_new, n_new, m_new), h

    carry0 = (C0.astype(jnp.float32), n0.astype(jnp.float32), m0.astype(jnp.float32))
    (C, n, m), hs = lax.scan(step, carry0, (qs, ks, vs, lis, lfs))
    hs = jnp.moveaxis(hs, 0, 2).reshape(B, ML_HEADS, nc * cs, ML_DV)[:, :, :L]
    return jnp.moveaxis(hs, 1, 2), C, n, m


def mem_kv(mem, g_mem, w_k, w_v):
    B = mem.shape[0]
    mn = rmsnorm(mem, g_mem)
    mk = (mn @ w_k).reshape(B, N_MEM, XA_HEADS, XA_DH)
    mv = (mn @ w_v).reshape(B, N_MEM, XA_HEADS, XA_DH)
    return mk, mv


def layer(x, conv_buf, h0, C0, n0, m0, mk, mv,
          g_mix, w_in, conv_w, conv_b, w_rg_a, b_rg_a, w_rg_x, b_rg_x, rg_lambda,
          b_ml_i, b_ml_f, g_rg_out, g_ml_out, w_out,
          g_xa, w_xa_q, w_xa_o, g_ffn, w_ffn_gate, w_ffn_up, w_ffn_down):
    B, L, _ = x.shape
    dt = x.dtype
    xn = rmsnorm(x, g_mix)
    z = xn @ w_in
    xr, conv_new = causal_conv(z[..., OFF_RGX:OFF_RGG], conv_buf, conv_w, conv_b)
    r = jax.nn.sigmoid(block_diag(xr, w_rg_a, b_rg_a).astype(jnp.float32))
    ig = jax.nn.sigmoid(block_diag(xr, w_rg_x, b_rg_x).astype(jnp.float32))
    h_rg, h_last = rglru(xr.astype(jnp.float32), r, ig, rg_lambda.astype(jnp.float32),
                         h0.astype(jnp.float32))
    y_rg = rmsnorm((h_rg.astype(dt) * jax.nn.gelu(z[..., OFF_RGG:OFF_Q])), g_rg_out)
    q = z[..., OFF_Q:OFF_K].reshape(B, L, ML_HEADS, ML_DK)
    k = z[..., OFF_K:OFF_V].reshape(B, L, ML_HEADS, ML_DK) * (ML_DK ** -0.5)
    v = z[..., OFF_V:OFF_O].reshape(B, L, ML_HEADS, ML_DV)
    logi = (z[..., OFF_I:OFF_F] + b_ml_i).astype(jnp.float32)
    logf = jax.nn.log_sigmoid((z[..., OFF_F:IN_W] + b_ml_f).astype(jnp.float32))
    h_ml, C_new, n_new, m_new = mlstm(q, k, v, logi, logf, C0, n0, m0)
    h_ml = rmsnorm(h_ml.astype(dt), g_ml_out.reshape(ML_HEADS, ML_DV)).reshape(B, L, ML_WIDTH)
    y_ml = h_ml * jax.nn.sigmoid(z[..., OFF_O:OFF_I])
    x = x + jnp.concatenate([y_rg, y_ml], axis=-1) @ w_out
    xq = (rmsnorm(x, g_xa) @ w_xa_q).reshape(B, L, XA_HEADS, XA_DH)
    s = jnp.einsum('blhd,bmhd->bhlm', xq, mk.astype(dt)).astype(jnp.float32) * (XA_DH ** -0.5)
    p = jax.nn.softmax(s, axis=-1).astype(dt)
    o = jnp.einsum('bhlm,bmhd->blhd', p, mv.astype(dt)).reshape(B, L, D_MODEL)
    x = x + o @ w_xa_o
    xf = rmsnorm(x, g_ffn)
    x = x + (jax.nn.silu(xf @ w_ffn_gate) * (xf @ w_ffn_up)) @ w_ffn_down
    return x, (h_last.astype(dt), conv_new.astype(dt), C_new.astype(dt), n_new.astype(dt), m_new.astype(dt))


def setup_inputs(seed: int = 0) -> dict:
    key = jax.random.key(seed)
    ks = jax.random.split(key, 40)
    f32 = jnp.float32
    nrm = lambda i, shape, s: jax.random.normal(ks[i], shape, f32) * s
    gain = lambda i, shape: 1.0 + 0.05 * jax.random.normal(ks[i], shape, f32)
    a0 = jax.random.uniform(ks[10], (DEPTH, RG_WIDTH), f32, 0.9, 0.999)
    return {
        "x_prompt": nrm(0, (BATCH, SEQ, D_MODEL), 1.0),
        "x_sample": nrm(1, (DEC_BATCH, DEC_SEQ, D_MODEL), 1.0),
        "mem_prompt": nrm(2, (BATCH, N_MEM, D_MODEL), 1.0),
        "state_rg_h": nrm(3, (DEPTH, DEC_BATCH, RG_WIDTH), 0.5),
        "state_rg_conv": nrm(4, (DEPTH, DEC_BATCH, CONV_W - 1, RG_WIDTH), 1.0),
        "state_ml_C": nrm(5, (DEPTH, DEC_BATCH, ML_HEADS, ML_DK, ML_DV), 0.1),
        "state_ml_n": nrm(6, (DEPTH, DEC_BATCH, ML_HEADS, ML_DK), 0.1),
        "state_ml_m": nrm(7, (DEPTH, DEC_BATCH, ML_HEADS), 1.0),
        "cache_mem_k": nrm(8, (DEPTH, DEC_BATCH, N_MEM, XA_HEADS, XA_DH), 1.0),
        "cache_mem_v": nrm(9, (DEPTH, DEC_BATCH, N_MEM, XA_HEADS, XA_DH), 1.0),
        "g_mix": gain(11, (DEPTH, D_MODEL)),
        "w_in": nrm(12, (DEPTH, D_MODEL, IN_W), D_MODEL ** -0.5),
        "conv_w": nrm(13, (DEPTH, CONV_W, RG_WIDTH), CONV_W ** -0.5),
        "conv_b": nrm(14, (DEPTH, RG_WIDTH), 0.02),
        "w_rg_a": nrm(15, (DEPTH, RG_BLOCKS, RG_BLOCK, RG_BLOCK), RG_BLOCK ** -0.5),
        "b_rg_a": nrm(16, (DEPTH, RG_WIDTH), 0.02),
        "w_rg_x": nrm(17, (DEPTH, RG_BLOCKS, RG_BLOCK, RG_BLOCK), RG_BLOCK ** -0.5),
        "b_rg_x": nrm(18, (DEPTH, RG_WIDTH), 0.02),
        "rg_lambda": jnp.log(a0) - jnp.log1p(-a0),
        "b_ml_i": nrm(19, (DEPTH, ML_HEADS), 0.1),
        "b_ml_f": 3.0 + jax.random.uniform(ks[20], (DEPTH, ML_HEADS), f32, 0.0, 3.0),
        "g_rg_out": gain(21, (DEPTH, RG_WIDTH)),
        "g_ml_out": gain(22, (DEPTH, ML_WIDTH)),
        "w_out": nrm(23, (DEPTH, D_MIX, D_MODEL), D_MIX ** -0.5),
        "g_xa": gain(24, (DEPTH, D_MODEL)),
        "g_mem": gain(25, (DEPTH, D_MODEL)),
        "w_xa_q": nrm(26, (DEPTH, D_MODEL, D_MODEL), D_MODEL ** -0.5),
        "w_xa_k": nrm(27, (DEPTH, D_MODEL, D_MODEL), D_MODEL ** -0.5),
        "w_xa_v": nrm(28, (DEPTH, D_MODEL, D_MODEL), D_MODEL ** -0.5),
        "w_xa_o": nrm(29, (DEPTH, D_MODEL, D_MODEL), D_MODEL ** -0.5),
        "g_ffn": gain(30, (DEPTH, D_MODEL)),
        "w_ffn_gate": nrm(31, (DEPTH, D_MODEL, D_FF), D_MODEL ** -0.5),
        "w_ffn_up": nrm(32, (DEPTH, D_MODEL, D_FF), D_MODEL ** -0.5),
        "w_ffn_down": nrm(33, (DEPTH, D_FF, D_MODEL), D_FF ** -0.5),
        "g_final": gain(34, (D_MODEL,)),
    }


def reference(x_prompt, x_sample, mem_prompt, state_rg_h, state_rg_conv, state_ml_C, state_ml_n,
              state_ml_m, cache_mem_k, cache_mem_v,
              g_mix, w_in, conv_w, conv_b, w_rg_a, b_rg_a, w_rg_x, b_rg_x, rg_lambda,
              b_ml_i, b_ml_f, g_rg_out, g_ml_out, w_out,
              g_xa, g_mem, w_xa_q, w_xa_k, w_xa_v, w_xa_o,
              g_ffn, w_ffn_gate, w_ffn_up, w_ffn_down, g_final):
    dt = x_prompt.dtype
    xp, xs = x_prompt, x_sample
    Bp = xp.shape[0]
    p_st, s_st, p_mk, p_mv = [], [], [], []
    for l in range(DEPTH):
        w = (g_mix[l], w_in[l], conv_w[l], conv_b[l], w_rg_a[l], b_rg_a[l], w_rg_x[l], b_rg_x[l],
             rg_lambda[l], b_ml_i[l], b_ml_f[l], g_rg_out[l], g_ml_out[l], w_out[l],
             g_xa[l], w_xa_q[l], w_xa_o[l], g_ffn[l], w_ffn_gate[l], w_ffn_up[l], w_ffn_down[l])
        mk, mv = mem_kv(mem_prompt, g_mem[l], w_xa_k[l], w_xa_v[l])
        xp, st_p = layer(xp,
                         jnp.zeros((Bp, CONV_W - 1, RG_WIDTH), dt),
                         jnp.zeros((Bp, RG_WIDTH), dt),
                         jnp.zeros((Bp, ML_HEADS, ML_DK, ML_DV), dt),
                         jnp.zeros((Bp, ML_HEADS, ML_DK), dt),
                         jnp.zeros((Bp, ML_HEADS), dt),
                         mk, mv, *w)
        p_st.append(st_p)
        p_mk.append(mk)
        p_mv.append(mv)
        xs, st_s = layer(xs, state_rg_conv[l], state_rg_h[l], state_ml_C[l], state_ml_n[l],
                         state_ml_m[l], cache_mem_k[l], cache_mem_v[l], *w)
        s_st.append(st_s)
    y_prompt = rmsnorm(xp, g_final)
    y_sample = rmsnorm(xs, g_final)
    stk = lambda lst, j: jnp.stack([s[j] for s in lst], axis=0)
    return (y_prompt, y_sample,
            stk(p_st, 0), stk(p_st, 1), stk(p_st, 2), stk(p_st, 3), stk(p_st, 4),
            jnp.stack(p_mk, axis=0), jnp.stack(p_mv, axis=0),
            stk(s_st, 0), stk(s_st, 1), stk(s_st, 2), stk(s_st, 3), stk(s_st, 4))
```

```cpp
#include <hip/hip_runtime.h>
#include <hip/hip_cooperative_groups.h>
#include <cstdio>
#include <cstdint>
namespace cg = cooperative_groups;

#ifndef MK_N_LAUNCHES
#define MK_N_LAUNCHES 1
#endif

#define LAS __attribute__((address_space(3)))
typedef unsigned short bf16_t;
typedef short bf16x8 __attribute__((ext_vector_type(8)));
typedef float f32x4 __attribute__((ext_vector_type(4)));
typedef unsigned u32x4 __attribute__((ext_vector_type(4)));
typedef unsigned u32x2 __attribute__((ext_vector_type(2)));

constexpr int DM = 2048, NP = 8192, NS = 128, MV = NP + NS, MA = 8448, ZW = 5120, INW = 5128, DFF = 5632, SEQ = 2048, NMEM = 256;
constexpr float EPS = 1e-6f;
constexpr int N_PHASES = 13;

constexpr size_t O_YP = 0, O_YS = O_YP + (size_t)NP * DM, O_PRGH = O_YS + (size_t)NS * DM, O_PRGC = O_PRGH + 4096, O_PMLC = O_PRGC + 12288,
                 O_PMLN = O_PMLC + 524288, O_PMLM = O_PMLN + 2048, O_PMK = O_PMLM + 16, O_PMV = O_PMK + 2097152, O_SRGH = O_PMV + 2097152,
                 O_SRGC = O_SRGH + 131072, O_SMLC = O_SRGC + 393216, O_SMLN = O_SMLC + 16777216, O_SMLM = O_SMLN + 65536, O_END = O_SMLM + 512;

constexpr size_t MiB = 1u << 20;
constexpr size_t WS_WIN = 1 * MiB, WS_WOUT = 21 * MiB, WS_WQ = 29 * MiB, WS_WKV = 37 * MiB, WS_WO = 53 * MiB, WS_WGU = 61 * MiB, WS_WD = 105 * MiB,
                 WS_WRG = 127 * MiB, WS_ABUF = 128 * MiB, WS_MN = 161 * MiB, WS_Z = 165 * MiB, WS_GATES = 248 * MiB, WS_YPRE = 249 * MiB,
                 WS_HPRE = 282 * MiB, WS_YMIX = 315 * MiB, WS_X1 = 348 * MiB, WS_SSQ1 = 414 * MiB, WS_SSQ2 = 416 * MiB, WS_QB = 418 * MiB,
                 WS_OB = 451 * MiB, WS_KB = 484 * MiB, WS_VT = 488 * MiB, WS_P = 492 * MiB, WS_H = 508 * MiB, WS_X1S = 600 * MiB, WS_X2S = 601 * MiB, WS_P3 = 604 * MiB, WS_P4 = 612 * MiB, WS_P6 = 620 * MiB, WS_P8 = 628 * MiB, WS_CPRE = 652 * MiB, WS_RGE = 685 * MiB, WS_MLS = 686 * MiB, WS_CIN = 687 * MiB, WS_CINF = 689 * MiB, WS_GL = 692 * MiB, WS_SLOTS = 693 * MiB, WS_END = 694 * MiB;

constexpr int LDS_BYTES = 147456;

__device__ __forceinline__ unsigned cvt_pk_bf16(float lo, float hi) { unsigned r; asm volatile("v_cvt_pk_bf16_f32 %0, %1, %2" : "=v"(r) : "v"(lo), "v"(hi)); return r; }
__device__ __forceinline__ float bf2f(unsigned short b) { return __uint_as_float((unsigned)b << 16); }
__device__ __forceinline__ bf16_t f2bf(float f) { return (bf16_t)(cvt_pk_bf16(f, 0.f) & 0xffffu); }
__device__ __forceinline__ float bflo(unsigned w) { return __uint_as_float(w << 16); }
__device__ __forceinline__ float bfhi(unsigned w) { return __uint_as_float(w & 0xffff0000u); }
__device__ __forceinline__ float wave_sum(float v) {
#pragma unroll
    for (int o = 1; o < 64; o <<= 1) v += __shfl_xor(v, o);
    return v;
}
__device__ __forceinline__ float wave_max(float v) {
#pragma unroll
    for (int o = 1; o < 64; o <<= 1) v = fmaxf(v, __shfl_xor(v, o));
    return v;
}
__device__ __forceinline__ float sigmoidf_(float x) { return 1.f / (1.f + __expf(-x)); }
__device__ __forceinline__ float gelu_tanh(float x) { const float u = 0.7978845608028654f * (x + 0.044715f * x * x * x); return 0.5f * x * (1.f + tanhf(u)); }
#define LDS_WAIT() asm volatile("s_waitcnt lgkmcnt(0)" ::: "memory")
#define LBAR() do { asm volatile("s_waitcnt lgkmcnt(0)" ::: "memory"); __builtin_amdgcn_s_barrier(); asm volatile("" ::: "memory"); } while (0)

namespace pg8 {
constexpr int BM = 256, BK = 64, HALF = 128, HTB = HALF * BK * 2, STAGE_BYTES = 8 * HTB, NXCD = 8, WGM = 8;
__host__ __device__ __forceinline__ int lds_byte(int r, int c) { const int st = (r >> 4) * 2 + (c >> 5), rr = r & 15, cc = c & 31, ob = rr * 64 + cc * 2; return st * 1024 + (ob ^ (((ob >> 9) & 1) << 5)); }
__host__ __device__ __forceinline__ void stage_rc(int b, int& R, int& C) { const int st = b / 1024, sb = b % 1024, swz = sb ^ (((sb >> 9) & 1) << 5); R = (st >> 1) * 16 + swz / 64; C = (st & 1) * 32 + (swz % 64) / 2; }
__host__ __device__ __forceinline__ int perm32(int rho) { const int n = rho >> 4, i = rho & 15; return 8 * (i >> 2) + 4 * n + (i & 3); }

struct Unit { int pm, pn; };

struct SchedStd {
    const char* A; const char* B; size_t sA, sB; int nM, nN, nwg, G, c;
    __device__ void init(const void* A_, const void* B_, int lda, int ldb, int M, int N, int G_, int c_) {
        A = (const char*)A_; B = (const char*)B_; sA = (size_t)BM * lda * 2; sB = (size_t)BM * ldb * 2; nM = M / BM; nN = N / BM; nwg = nM * nN; G = G_; c = c_; }
    __device__ bool next(int i, Unit& u) const {
        const long L = (long)i * G + c; if (L >= nwg) return false;
        int wgid = (int)L; { const int q = nwg / NXCD, r = nwg % NXCD, xcd = wgid % NXCD, off = wgid / NXCD; wgid = (xcd < r ? xcd * (q + 1) : r * (q + 1) + (xcd - r) * q) + off; }
        const int nig = WGM * nN, gid = wgid / nig, fm = gid * WGM, gsz = (nM - fm) < WGM ? (nM - fm) : WGM;
        u.pm = fm + ((wgid % nig) % gsz); u.pn = (wgid % nig) / gsz; return true;
    }
    __device__ __forceinline__ const char* aptr(const Unit& u) const { return A + (size_t)u.pm * sA; }
    __device__ __forceinline__ const char* bptr(const Unit& u) const { return B + (size_t)u.pn * sB; }
};
struct SchedS {
    const char* Q; const char* Kb; int G, c;
    __device__ bool next(int i, Unit& u) const { const int L = i * G + c; if (L >= 128) return false; const int b = L >> 5, h = (L >> 3) & 3, qt = L & 7; u.pm = b * 8 + qt; u.pn = h; return true; }
    __device__ __forceinline__ const char* aptr(const Unit& u) const { return Q + ((size_t)u.pm * 256 * DM + (size_t)u.pn * 512) * 2; }
    __device__ __forceinline__ const char* bptr(const Unit& u) const { return Kb + ((size_t)(u.pm >> 3) * 256 * DM + (size_t)u.pn * 512) * 2; }
};
struct SchedPV {
    const char* P; const char* VT; int G, c;
    __device__ bool next(int i, Unit& u) const { const int L = i * G + c; if (L >= 256) return false; const int bh = L >> 4, qt = (L >> 1) & 7, nh = L & 1; u.pm = (bh >> 2) * 8 + qt; u.pn = (bh & 3) * 2 + nh; return true; }
    __device__ __forceinline__ const char* aptr(const Unit& u) const { const int bh = (u.pm >> 3) * 4 + (u.pn >> 1); return P + ((size_t)bh * 2048 + (size_t)(u.pm & 7) * 256) * 256 * 2; }
    __device__ __forceinline__ const char* bptr(const Unit& u) const { const int bh = (u.pm >> 3) * 4 + (u.pn >> 1); return VT + ((size_t)bh * 512 + (size_t)(u.pn & 1) * 256) * 256 * 2; }
};

typedef f32x4 Acc[2][2][4][2];
__device__ __forceinline__ u32x4 pack8(const f32x4 v0, const f32x4 v1) { u32x4 w; w.x = cvt_pk_bf16(v0[0], v0[1]); w.y = cvt_pk_bf16(v0[2], v0[3]); w.z = cvt_pk_bf16(v1[0], v1[1]); w.w = cvt_pk_bf16(v1[2], v1[3]); return w; }

struct EpiBf16 {
    static constexpr bool PERM = true, AFTER_DRAIN = false;
    bf16_t* O; int ldc;
    __device__ __forceinline__ void operator()(const Acc& acc, const Unit& u, int wr, int wc, int fr, int fq) const {
        const int row0 = u.pm * BM + wr * 64 + fr, col0 = u.pn * BM + wc * 32 + 8 * fq;
#pragma unroll
        for (int ai = 0; ai < 2; ++ai)
#pragma unroll
            for (int m = 0; m < 4; ++m) { bf16_t* rowp = O + (size_t)(row0 + ai * HALF + m * 16) * ldc + col0;
#pragma unroll
                for (int bj = 0; bj < 2; ++bj) *(u32x4*)(rowp + bj * HALF) = pack8(acc[ai][bj][m][0], acc[ai][bj][m][1]); }
    }
};
struct EpiKV {
    static constexpr bool PERM = true, AFTER_DRAIN = false;
    float* outK; float* outV; bf16_t* KB; bf16_t* VT;
    __device__ __forceinline__ void operator()(const Acc& acc, const Unit& u, int wr, int wc, int fr, int fq) const {
        const int row0 = u.pm * BM + wr * 64 + fr, col0 = (u.pn & 7) * BM + wc * 32 + 8 * fq; const bool isV = u.pn >= 8;
#pragma unroll
        for (int ai = 0; ai < 2; ++ai)
#pragma unroll
            for (int m = 0; m < 4; ++m) { const int r = row0 + ai * HALF + m * 16;
#pragma unroll
                for (int bj = 0; bj < 2; ++bj) { const int c = col0 + bj * HALF; const f32x4 v0 = acc[ai][bj][m][0], v1 = acc[ai][bj][m][1];
                    float* o = (isV ? outV : outK) + (size_t)r * DM + c; *(f32x4*)o = v0; *(f32x4*)(o + 4) = v1;
                    if (!isV) *(u32x4*)(KB + (size_t)r * DM + c) = pack8(v0, v1);
                    else { const int b = r >> 8, mm = r & 255, h = c >> 9, d = c & 511; bf16_t* base = VT + ((size_t)((b * 4 + h) * 512 + d)) * 256 + mm;
#pragma unroll
                        for (int e = 0; e < 4; ++e) { base[(size_t)e * 256] = f2bf(v0[e]); base[(size_t)(4 + e) * 256] = f2bf(v1[e]); } } } }
    }
};
template <int MODE> struct EpiRes {
    static constexpr bool PERM = true, AFTER_DRAIN = false;
    const float* xp; const float* xs; float* X1; float* yp; float* ys; const float* g; bf16_t* Aout; float* SSQ;
    __device__ __forceinline__ void operator()(const Acc& acc, const Unit& u, int wr, int wc, int fr, int fq) const {
        const int row0 = u.pm * BM + wr * 64 + fr, col0 = u.pn * BM + wc * 32 + 8 * fq;
        f32x4 gv[2][2];
        if (MODE != 3) {
#pragma unroll
            for (int bj = 0; bj < 2; ++bj)
#pragma unroll
                for (int n = 0; n < 2; ++n) gv[bj][n] = *(const f32x4*)(g + col0 + bj * HALF + 4 * n); }
#pragma unroll
        for (int ai = 0; ai < 2; ++ai)
#pragma unroll
            for (int m = 0; m < 4; ++m) { const int r = row0 + ai * HALF + m * 16;
                const float* src; float* dst;
                if (MODE == 1) { const int rc = r < MV ? r : MV - 1; src = rc < NP ? xp + (size_t)rc * DM : xs + (size_t)(rc - NP) * DM; dst = X1 + (size_t)r * DM; }
                else if (MODE == 2) { src = X1 + (size_t)r * DM; dst = X1 + (size_t)r * DM; }
                else { src = X1 + (size_t)r * DM; dst = r < NP ? yp + (size_t)r * DM : (r < MV ? ys + (size_t)(r - NP) * DM : X1 + (size_t)r * DM); }
                float ss = 0.f;
#pragma unroll
                for (int bj = 0; bj < 2; ++bj) { const int c = col0 + bj * HALF;
                    const f32x4 v0 = *(const f32x4*)(src + c) + acc[ai][bj][m][0], v1 = *(const f32x4*)(src + c + 4) + acc[ai][bj][m][1];
                    *(f32x4*)(dst + c) = v0; *(f32x4*)(dst + c + 4) = v1;
                    if (MODE != 3) { ss += (v0[0] * v0[0] + v0[1] * v0[1]) + (v0[2] * v0[2] + v0[3] * v0[3]) + (v1[0] * v1[0] + v1[1] * v1[1]) + (v1[2] * v1[2] + v1[3] * v1[3]);
                        *(u32x4*)(Aout + (size_t)r * DM + c) = pack8(v0 * gv[bj][0], v1 * gv[bj][1]); } }
                if (MODE != 3) { ss += __shfl_xor(ss, 16); ss += __shfl_xor(ss, 32); if (fq == 0) SSQ[(size_t)r * 32 + u.pn * 4 + wc] = ss; }
                if (m & 1) asm volatile("" ::: "memory"); }
    }
};
__device__ __forceinline__ float row_rstd(const float* SSQ, int r, int fq) {
    const float* p = SSQ + (size_t)r * 32 + fq * 8; const f32x4 t0 = *(const f32x4*)p, t1 = *(const f32x4*)(p + 4);
    float s = (t0[0] + t0[1]) + (t0[2] + t0[3]) + (t1[0] + t1[1]) + (t1[2] + t1[3]); s += __shfl_xor(s, 16); s += __shfl_xor(s, 32);
    return rsqrtf(s * (1.f / DM) + EPS);
}
struct EpiQ {
    static constexpr bool PERM = true, AFTER_DRAIN = false;
    const float* SSQ; bf16_t* O; float scale;
    __device__ __forceinline__ void operator()(const Acc& acc, const Unit& u, int wr, int wc, int fr, int fq) const {
        const int row0 = u.pm * BM + wr * 64 + fr, col0 = u.pn * BM + wc * 32 + 8 * fq;
#pragma unroll
        for (int ai = 0; ai < 2; ++ai)
#pragma unroll
            for (int m = 0; m < 4; ++m) { const int r = row0 + ai * HALF + m * 16; const float rs = row_rstd(SSQ, r, fq) * scale; bf16_t* rowp = O + (size_t)r * DM + col0;
#pragma unroll
                for (int bj = 0; bj < 2; ++bj) *(u32x4*)(rowp + bj * HALF) = pack8(acc[ai][bj][m][0] * rs, acc[ai][bj][m][1] * rs); }
    }
};
struct EpiGU {
    static constexpr bool PERM = true, AFTER_DRAIN = false;
    const float* SSQ; bf16_t* H;
    __device__ __forceinline__ void operator()(const Acc& acc, const Unit& u, int wr, int wc, int fr, int fq) const {
        const int row0 = u.pm * BM + wr * 64 + fr, col0 = u.pn * HALF + wc * 32 + 8 * fq;
#pragma unroll
        for (int ai = 0; ai < 2; ++ai)
#pragma unroll
            for (int m = 0; m < 4; ++m) { const int r = row0 + ai * HALF + m * 16; const float rs = SSQ ? row_rstd(SSQ, r, fq) : 1.f; f32x4 hv[2];
#pragma unroll
                for (int n = 0; n < 2; ++n)
#pragma unroll
                    for (int j = 0; j < 4; ++j) { const float gg = acc[ai][0][m][n][j] * rs, uu = acc[ai][1][m][n][j] * rs; hv[n][j] = gg * sigmoidf_(gg) * uu; }
                *(u32x4*)(H + (size_t)r * DFF + col0) = pack8(hv[0], hv[1]); }
    }
};
struct EpiSoftmax {
    static constexpr bool PERM = true, AFTER_DRAIN = true;
    bf16_t* P;
    __device__ __forceinline__ void operator()(const Acc&, const Unit&, int, int, int, int) const {}
    __device__ __forceinline__ void fused(Acc& acc, const Unit& u, int wr, int wc, int fr, int fq, LAS unsigned char* lds, int wid, int lane) const {
        LAS float* PM = (LAS float*)lds; LAS float* PS = (LAS float*)(lds + 4096);
#pragma unroll
        for (int ai = 0; ai < 2; ++ai)
#pragma unroll
            for (int m = 0; m < 4; ++m) { float mx = -3.0e38f;
#pragma unroll
                for (int bj = 0; bj < 2; ++bj)
#pragma unroll
                    for (int n = 0; n < 2; ++n) { const f32x4 x = acc[ai][bj][m][n]; mx = fmaxf(mx, fmaxf(fmaxf(x[0], x[1]), fmaxf(x[2], x[3]))); }
                mx = fmaxf(mx, __shfl_xor(mx, 16)); mx = fmaxf(mx, __shfl_xor(mx, 32));
                if (fq == 0) PM[(ai * HALF + wr * 64 + m * 16 + fr) * 4 + wc] = mx; }
        LDS_WAIT(); __builtin_amdgcn_s_barrier(); asm volatile("" ::: "memory");
#pragma unroll
        for (int ai = 0; ai < 2; ++ai)
#pragma unroll
            for (int m = 0; m < 4; ++m) { const int rl = ai * HALF + wr * 64 + m * 16 + fr; const f32x4 pm = *(const LAS f32x4*)(PM + rl * 4);
                const float M = fmaxf(fmaxf(pm[0], pm[1]), fmaxf(pm[2], pm[3])); float s = 0.f;
#pragma unroll
                for (int bj = 0; bj < 2; ++bj)
#pragma unroll
                    for (int n = 0; n < 2; ++n)
#pragma unroll
                        for (int j = 0; j < 4; ++j) { const float e = __expf(acc[ai][bj][m][n][j] - M); acc[ai][bj][m][n][j] = e; s += e; }
                s += __shfl_xor(s, 16); s += __shfl_xor(s, 32);
                if (fq == 0) PS[rl * 4 + wc] = s; }
        LDS_WAIT(); __builtin_amdgcn_s_barrier(); asm volatile("" ::: "memory");
        const int b = u.pm >> 3, qt = u.pm & 7, h = u.pn;
#pragma unroll
        for (int ai = 0; ai < 2; ++ai)
#pragma unroll
            for (int m = 0; m < 4; ++m) { const int rl = ai * HALF + wr * 64 + m * 16 + fr; const f32x4 ps = *(const LAS f32x4*)(PS + rl * 4);
                const float inv = 1.f / ((ps[0] + ps[1]) + (ps[2] + ps[3]));
                bf16_t* rowp = P + ((size_t)((b * 4 + h) * 2048 + qt * 256 + rl)) * 256 + wc * 32 + 8 * fq;
#pragma unroll
                for (int bj = 0; bj < 2; ++bj) *(u32x4*)(rowp + bj * HALF) = pack8(acc[ai][bj][m][0] * inv, acc[ai][bj][m][1] * inv); }
        LDS_WAIT(); __builtin_amdgcn_s_barrier(); asm volatile("" ::: "memory");
    }
};

struct SchedSK {
    const char* A; const char* B; int ldb, npn, nks, G, c;
    __device__ bool next(int i, Unit& u) const { const int L = i * G + c; if (L >= npn * nks) return false; u.pn = L % npn; u.pm = L / npn; return true; }
    __device__ __forceinline__ const char* aptr(const Unit& u) const { return A + (size_t)u.pm * 512; }
    __device__ __forceinline__ const char* bptr(const Unit& u) const { return B + ((size_t)u.pn * 256 * ldb + (size_t)u.pm * 256) * 2; }
};
struct EpiPartial {
    static constexpr bool PERM = true, AFTER_DRAIN = false;
    float* D; int ld;
    __device__ __forceinline__ void operator()(const Acc& acc, const Unit& u, int wr, int wc, int fr, int fq) const {
        const int col0 = u.pn * BM + wc * 32 + 8 * fq;
#pragma unroll
        for (int m = 0; m < 4; ++m) { float* rowp = D + ((size_t)u.pm * 128 + wr * 64 + m * 16 + fr) * ld + col0;
#pragma unroll
            for (int bj = 0; bj < 2; ++bj) { *(f32x4*)(rowp + bj * HALF) = acc[0][bj][m][0]; *(f32x4*)(rowp + bj * HALF + 4) = acc[0][bj][m][1]; } }
    }
};

struct EpiFinal {
    static constexpr bool PERM = true, AFTER_DRAIN = true;
    const float* X1; float* yp; const float* g; float* slots; unsigned* cnt;
    __device__ __forceinline__ void operator()(const Acc&, const Unit&, int, int, int, int) const {}
    __device__ __forceinline__ void fused(Acc& acc, const Unit& u, int wr, int wc, int fr, int fq, LAS unsigned char* lds, int wid, int lane) const {
        LAS float* P = (LAS float*)lds;
        LAS float* S = (LAS float*)(lds + 4096);
        const int col0 = u.pn * BM + wc * 32 + 8 * fq;
#pragma unroll
        for (int ai = 0; ai < 2; ++ai)
#pragma unroll
            for (int m = 0; m < 4; ++m) { const int rl = ai * HALF + wr * 64 + m * 16 + fr; const float* src = X1 + (size_t)(u.pm * BM + rl) * DM + col0; float ss = 0.f;
#pragma unroll
                for (int bj = 0; bj < 2; ++bj) { acc[ai][bj][m][0] += *(const f32x4*)(src + bj * HALF); acc[ai][bj][m][1] += *(const f32x4*)(src + bj * HALF + 4);
                    const f32x4 v0 = acc[ai][bj][m][0], v1 = acc[ai][bj][m][1];
                    ss += (v0[0] * v0[0] + v0[1] * v0[1]) + (v0[2] * v0[2] + v0[3] * v0[3]) + (v1[0] * v1[0] + v1[1] * v1[1]) + (v1[2] * v1[2] + v1[3] * v1[3]); }
                ss += __shfl_xor(ss, 16); ss += __shfl_xor(ss, 32);
                if (fq == 0) P[rl * 4 + wc] = ss;
                if (m & 1) asm volatile("" ::: "memory"); }
        LDS_WAIT(); __builtin_amdgcn_s_barrier(); asm volatile("" ::: "memory");
        const int row = wid * 32 + (lane & 31);
        if (lane < 32) { const f32x4 p = *(const LAS f32x4*)(P + row * 4);
            __hip_atomic_store(slots + ((size_t)(u.pm * BM + row)) * 8 + u.pn, (p[0] + p[1]) + (p[2] + p[3]), __ATOMIC_RELAXED, __HIP_MEMORY_SCOPE_AGENT); }
        asm volatile("s_waitcnt vmcnt(0)" ::: "memory");
        if (lane == 0) __hip_atomic_fetch_add(cnt + 64 * u.pm, 1u, __ATOMIC_RELAXED, __HIP_MEMORY_SCOPE_AGENT);
        if (wid == 0) {
            unsigned sp = 0u;
            while ((unsigned)__builtin_amdgcn_readfirstlane(__hip_atomic_load(cnt + 64 * u.pm, __ATOMIC_RELAXED, __HIP_MEMORY_SCOPE_AGENT)) < 64u) { __builtin_amdgcn_s_sleep(2); if (++sp > (1u << 20)) break; }
            __builtin_amdgcn_fence(__ATOMIC_ACQUIRE, "agent");
        }
        asm volatile("s_waitcnt vmcnt(0) lgkmcnt(0)" ::: "memory"); __builtin_amdgcn_s_barrier(); asm volatile("" ::: "memory");
        if (lane < 32) { const float* sl = slots + ((size_t)(u.pm * BM + row)) * 8; float tot = 0.f;
#pragma unroll
            for (int t = 0; t < 8; ++t) tot += __hip_atomic_load(sl + t, __ATOMIC_RELAXED, __HIP_MEMORY_SCOPE_AGENT);
            S[row] = rsqrtf(tot * (1.f / DM) + EPS); }
        LDS_WAIT(); __builtin_amdgcn_s_barrier(); asm volatile("" ::: "memory");
        f32x4 gv[2][2];
#pragma unroll
        for (int bj = 0; bj < 2; ++bj)
#pragma unroll
            for (int n = 0; n < 2; ++n) gv[bj][n] = *(const f32x4*)(g + col0 + bj * HALF + 4 * n);
#pragma unroll
        for (int ai = 0; ai < 2; ++ai)
#pragma unroll
            for (int m = 0; m < 4; ++m) { const int rl = ai * HALF + wr * 64 + m * 16 + fr; const float rs = S[rl]; float* dst = yp + (size_t)(u.pm * BM + rl) * DM + col0;
#pragma unroll
                for (int bj = 0; bj < 2; ++bj) { *(f32x4*)(dst + bj * HALF) = acc[ai][bj][m][0] * rs * gv[bj][0]; *(f32x4*)(dst + bj * HALF + 4) = acc[ai][bj][m][1] * rs * gv[bj][1]; } }
        LDS_WAIT(); __builtin_amdgcn_s_barrier(); asm volatile("" ::: "memory");
    }
};

template <class Epi, class Sched, bool ALIGN_EPI>
__device__ __forceinline__ void gemm_phase(LAS unsigned char* lds, const int lda, const int ldb, const int K, const Sched& S, const Epi& E) {
    const int tid = threadIdx.x, wid = __builtin_amdgcn_readfirstlane(tid >> 6), lane = tid & 63, wr = wid >> 2, wc = wid & 3, fr = lane & 15, fq = lane >> 4;
    const int nt = K / BK;
    unsigned voffA[2], voffB[2];
#pragma unroll
    for (int i = 0; i < 2; ++i) { int R, C; stage_rc(tid * 16 + i * 8192, R, C); const int Rb = Epi::PERM ? ((R & ~31) + perm32(R & 31)) : R;
        voffA[i] = (unsigned)(R * lda + C) * 2u; voffB[i] = (unsigned)(Rb * ldb + C) * 2u; }
    const size_t kstep = (size_t)(BK * 2);
    const size_t hA = (size_t)HALF * lda * 2, hB = (size_t)HALF * ldb * 2;
    const unsigned ldsw = (unsigned)wid * 1024u;
    const int aoff = lds_byte(wr * 64 + fr, fq * 8), boff = lds_byte(wc * 32 + fr, fq * 8);
#define PG8_SA(b, h) (((b) * 2 + (h)) * HTB)
#define PG8_SB(b, h) ((4 + (b) * 2 + (h)) * HTB)
#define PG8_STAGE(bufoff, gbase, voff) do { _Pragma("unroll") for (int _i = 0; _i < 2; ++_i) \
        __builtin_amdgcn_global_load_lds((const unsigned*)((const char*)(gbase) + (voff)[_i]), (LAS unsigned*)(lds + (bufoff) + ldsw + _i * 8192), 16, 0, 0); } while (0)
#define PG8_LDA(dst, b, h) do { _Pragma("unroll") for (int m = 0; m < 4; ++m) _Pragma("unroll") for (int k = 0; k < 2; ++k) dst[m][k] = *(const LAS bf16x8*)(lds + PG8_SA(b, h) + aoff + m * 2048 + k * 1024); } while (0)
#define PG8_LDB(dst, b, h) do { _Pragma("unroll") for (int n = 0; n < 2; ++n) _Pragma("unroll") for (int k = 0; k < 2; ++k) dst[n][k] = *(const LAS bf16x8*)(lds + PG8_SB(b, h) + boff + n * 2048 + k * 1024); } while (0)
#define PG8_MMA(ai, bj, At, Bt) do { __builtin_amdgcn_s_setprio(1); _Pragma("unroll") for (int m = 0; m < 4; ++m) _Pragma("unroll") for (int n = 0; n < 2; ++n) _Pragma("unroll") for (int k = 0; k < 2; ++k) \
        acc[ai][bj][m][n] = __builtin_amdgcn_mfma_f32_16x16x32_bf16(Bt[n][k], At[m][k], acc[ai][bj][m][n], 0, 0, 0); __builtin_amdgcn_s_setprio(0); } while (0)
#define PG8_WAIT_V(n) asm volatile("s_waitcnt vmcnt(" #n ")" ::: "memory")
#define PG8_WAIT_L(n) asm volatile("s_waitcnt lgkmcnt(" #n ")" ::: "memory")
#define PG8_BAR __builtin_amdgcn_s_barrier()
#define PG8_SCHED __builtin_amdgcn_sched_barrier(0)
    Unit cur, nxt; int ui = 0;
    if (!S.next(0, cur)) return;
    Acc acc;
#pragma unroll
    for (int a = 0; a < 2; ++a)
#pragma unroll
        for (int b = 0; b < 2; ++b)
#pragma unroll
            for (int m = 0; m < 4; ++m)
#pragma unroll
                for (int n = 0; n < 2; ++n) acc[a][b][m][n] = (f32x4){0.f, 0.f, 0.f, 0.f};
    bf16x8 At[4][2], B0[2][2], B1[2][2];
    const char* cA = S.aptr(cur); const char* cB = S.bptr(cur);
    PG8_STAGE(PG8_SB(0, 0), cB, voffB); PG8_STAGE(PG8_SB(0, 1), cB + hB, voffB); PG8_STAGE(PG8_SA(0, 0), cA, voffA); PG8_STAGE(PG8_SA(0, 1), cA + hA, voffA);
    if (wr == 1) PG8_BAR;
    PG8_WAIT_V(2); PG8_BAR;
    PG8_STAGE(PG8_SB(1, 0), cB + kstep, voffB); PG8_STAGE(PG8_SA(1, 0), cA + kstep, voffA); PG8_STAGE(PG8_SB(1, 1), cB + hB + kstep, voffB);
    PG8_WAIT_V(6); PG8_BAR;
    for (;;) {
        const bool has_next = S.next(ui + 1, nxt);
        const char* nA = has_next ? S.aptr(nxt) : cA; const char* nB = has_next ? S.bptr(nxt) : cB;
#pragma unroll 1
        for (int t = 0; t < nt; t += 2) {
            const bool last = (t == nt - 2);
            const char* a1 = cA + (size_t)(t + 1) * kstep;
            const char* a2 = last ? nA : cA + (size_t)(t + 2) * kstep; const char* b2 = last ? nB : cB + (size_t)(t + 2) * kstep;
            const char* a3 = a2 + kstep; const char* b3 = b2 + kstep;
            PG8_LDB(B0, 0, 0); PG8_LDB(B1, 0, 1); PG8_SCHED; PG8_LDA(At, 0, 0); PG8_STAGE(PG8_SA(1, 1), a1 + hA, voffA);
            PG8_WAIT_V(8); PG8_WAIT_L(0); PG8_BAR; PG8_MMA(0, 0, At, B0); PG8_MMA(0, 1, At, B1); PG8_BAR; PG8_SCHED;
            PG8_LDA(At, 0, 1); PG8_STAGE(PG8_SB(0, 0), b2, voffB); PG8_STAGE(PG8_SB(0, 1), b2 + hB, voffB); PG8_STAGE(PG8_SA(0, 0), a2, voffA);
            PG8_WAIT_V(8); PG8_WAIT_L(0); PG8_BAR; PG8_MMA(1, 0, At, B0); PG8_MMA(1, 1, At, B1); PG8_BAR; PG8_SCHED;
            PG8_LDB(B0, 1, 0); PG8_LDB(B1, 1, 1); PG8_SCHED; PG8_LDA(At, 1, 0); PG8_STAGE(PG8_SA(0, 1), a2 + hA, voffA);
            PG8_WAIT_V(8); PG8_WAIT_L(0); PG8_BAR; PG8_MMA(0, 0, At, B0); PG8_MMA(0, 1, At, B1); PG8_BAR; PG8_SCHED;
            PG8_LDA(At, 1, 1); PG8_STAGE(PG8_SB(1, 0), b3, voffB); PG8_STAGE(PG8_SB(1, 1), b3 + hB, voffB); PG8_STAGE(PG8_SA(1, 0), a3, voffA);
            PG8_WAIT_V(8); PG8_WAIT_L(0); PG8_BAR; PG8_MMA(1, 0, At, B0); PG8_MMA(1, 1, At, B1); PG8_BAR; PG8_SCHED;
        }
        if constexpr (ALIGN_EPI) { if (wr == 0) PG8_BAR; }
        if constexpr (!Epi::AFTER_DRAIN) { E(acc, cur, wr, wc, fr, fq); }
        if (!has_next) break;
#pragma unroll
        for (int a = 0; a < 2; ++a)
#pragma unroll
            for (int b = 0; b < 2; ++b)
#pragma unroll
                for (int m = 0; m < 4; ++m)
#pragma unroll
                    for (int n = 0; n < 2; ++n) acc[a][b][m][n] = (f32x4){0.f, 0.f, 0.f, 0.f};
        cur = nxt; cA = nA; cB = nB; ++ui;
        if constexpr (ALIGN_EPI) { if (wr == 1) PG8_BAR; }
    }
    PG8_WAIT_V(0);
    if constexpr (!ALIGN_EPI) { if (wr == 0) PG8_BAR; }
    PG8_BAR;
    if constexpr (Epi::AFTER_DRAIN) { E.fused(acc, cur, wr, wc, fr, fq, lds, wid, lane); }
#undef PG8_SA
#undef PG8_SB
#undef PG8_STAGE
#undef PG8_LDA
#undef PG8_LDB
#undef PG8_MMA
#undef PG8_WAIT_V
#undef PG8_WAIT_L
#undef PG8_BAR
#undef PG8_SCHED
}
}

struct Args { const float* in[35]; float* out; unsigned char* ws; int ph_lo, ph_hi; };
enum { I_XP = 0, I_XS, I_MEM, I_SRGH, I_SRGC, I_SMLC, I_SMLN, I_SMLM, I_CK, I_CV, I_GMIX, I_WIN, I_CONVW, I_CONVB, I_WRGA, I_BRGA, I_WRGX, I_BRGX, I_LAM,
       I_BMLI, I_BMLF, I_GRG, I_GML, I_WOUT, I_GXA, I_GMEM, I_WQ, I_WK, I_WV, I_WO, I_GFFN, I_WG, I_WU, I_WD, I_GFIN };

__device__ __forceinline__ void tr_item(const float* W, int ldw, bf16_t* dst, int ldd, LAS float* scr, int lane) {
#pragma unroll
    for (int hf = 0; hf < 2; ++hf) { float v[32];
#pragma unroll
        for (int kk = 0; kk < 32; ++kk) v[kk] = W[(size_t)(hf * 32 + kk) * ldw + lane];
#pragma unroll
        for (int kk = 0; kk < 32; ++kk) scr[(hf * 32 + kk) * 65 + lane] = v[kk]; }
    LDS_WAIT();
    const int c = lane & 7;
#pragma unroll
    for (int j = 0; j < 8; ++j) { const int n = (lane >> 3) + 8 * j; const LAS float* s = scr + (8 * c) * 65 + n;
        u32x4 o; o.x = cvt_pk_bf16(s[0], s[65]); o.y = cvt_pk_bf16(s[2 * 65], s[3 * 65]); o.z = cvt_pk_bf16(s[4 * 65], s[5 * 65]); o.w = cvt_pk_bf16(s[6 * 65], s[7 * 65]);
        *(u32x4*)(dst + (size_t)n * ldd + 8 * c) = o; }
    LDS_WAIT();
}
template <int MAP> __device__ __forceinline__ void tr_mat(int it, const float* W, int ldw, int ncols, bf16_t* dst, int ldd, LAS float* scr, int lane) {
    const int nblk = ncols / 64, kb = it / nblk, nb = it % nblk, k0 = kb * 64, n0 = nb * 64;
    const int drow = MAP == 0 ? n0 : ((n0 >> 7) * 256 + (n0 & 127) + (MAP == 2 ? 128 : 0));
    tr_item(W + (size_t)k0 * ldw + n0, ldw, dst + (size_t)drow * ldd + k0, ldd, scr, lane);
}
__device__ __forceinline__ void pro_row(const float* xrow, const float* g, bf16_t* orow, const float* wg, float* gates_out, int lane) {
    f32x4 v[8]; float ss = 0.f;
#pragma unroll
    for (int j = 0; j < 8; ++j) { v[j] = *(const f32x4*)(xrow + 4 * lane + 256 * j); ss += (v[j][0] * v[j][0] + v[j][1] * v[j][1]) + (v[j][2] * v[j][2] + v[j][3] * v[j][3]); }
    ss = wave_sum(ss); const float rstd = rsqrtf(ss * (1.f / DM) + EPS);
    f32x4 ga0 = {0.f, 0.f, 0.f, 0.f}, ga1 = {0.f, 0.f, 0.f, 0.f};
#pragma unroll
    for (int j = 0; j < 8; ++j) { const f32x4 gj = *(const f32x4*)(g + 4 * lane + 256 * j); v[j] = v[j] * rstd * gj;
        u32x2 w; w.x = cvt_pk_bf16(v[j][0], v[j][1]); w.y = cvt_pk_bf16(v[j][2], v[j][3]); *(u32x2*)(orow + 4 * lane + 256 * j) = w;
        if (wg) {
#pragma unroll
            for (int e = 0; e < 4; ++e) { const float* wp = wg + ((j * 4 + e) * 64 + lane) * 4; ga0 += v[j][e] * *(const f32x4*)wp; ga1 += v[j][e] * *(const f32x4*)(wp + 8192); } } }
    if (wg) {
#pragma unroll
        for (int q = 0; q < 4; ++q) { ga0[q] = wave_sum(ga0[q]); ga1[q] = wave_sum(ga1[q]); }
        if (lane == 0) { *(f32x4*)gates_out = ga0; *(f32x4*)(gates_out + 4) = ga1; } }
}
__device__ __forceinline__ void phase_prologue(const Args& a, unsigned char* lds_, int G) {
    const int tid = threadIdx.x, lane = tid & 63, wave = tid >> 6;
    LAS float* scr = (LAS float*)((LAS unsigned char*)lds_ + wave * 16640);
    const int gw = blockIdx.x * 8 + wave, NGW = G * 8;
    unsigned char* ws = a.ws;
    constexpr int I_IN = 32 * 80, I_SQ = 32 * 32, I_RG = 8 * 4;
    constexpr int NITEMS = I_IN + 2 * I_SQ + 2 * I_RG;
    for (int it = gw; it < NITEMS; it += NGW) {
        int r = it;
        if (r < I_IN) { tr_mat<0>(r, a.in[I_WIN], INW, ZW, (bf16_t*)(ws + WS_WIN), DM, scr, lane); continue; } r -= I_IN;
        if (r < I_SQ) { tr_mat<0>(r, a.in[I_WK], DM, DM, (bf16_t*)(ws + WS_WKV), DM, scr, lane); continue; } r -= I_SQ;
        if (r < I_SQ) { tr_mat<0>(r, a.in[I_WV], DM, DM, (bf16_t*)(ws + WS_WKV) + (size_t)DM * DM, DM, scr, lane); continue; } r -= I_SQ;
        if (r < I_RG) { const int blk = r >> 2; tr_mat<0>(r & 3, a.in[I_WRGA] + blk * 16384, 128, 128, (bf16_t*)(ws + WS_WRG) + blk * 32768, 128, scr, lane); continue; } r -= I_RG;
        { const int blk = r >> 2; tr_mat<0>(r & 3, a.in[I_WRGX] + blk * 16384, 128, 128, (bf16_t*)(ws + WS_WRG) + blk * 32768 + 128 * 128, 128, scr, lane); }
    }
    bf16_t* ABUF = (bf16_t*)(ws + WS_ABUF); float* GATES = (float*)(ws + WS_GATES);
    __syncthreads();
    float* wgl = (float*)lds_;
    for (int idx = tid; idx < 4096; idx += 512) { const int k = idx >> 1, hf = idx & 1; const int slot = ((k >> 8) * 4 + (k & 3)) * 64 + ((k & 255) >> 2);
        *(f32x4*)(wgl + hf * 8192 + slot * 4) = *(const f32x4*)(a.in[I_WIN] + (size_t)k * INW + ZW + hf * 4); }
    __syncthreads();
    for (int r = gw; r < MA; r += NGW) {
        if (r < MV) { const float* xrow = r < NP ? a.in[I_XP] + (size_t)r * DM : a.in[I_XS] + (size_t)(r - NP) * DM;
            pro_row(xrow, a.in[I_GMIX], ABUF + (size_t)r * DM, wgl, GATES + (size_t)r * 8, lane); }
        else {
#pragma unroll
            for (int j = 0; j < 8; ++j) *(u32x2*)(ABUF + (size_t)r * DM + 4 * lane + 256 * j) = (u32x2){0u, 0u}; }
    }
    for (int r = gw; r < 1024; r += NGW) pro_row(a.in[I_MEM] + (size_t)r * DM, a.in[I_GMEM], (bf16_t*)(ws + WS_MN) + (size_t)r * DM, nullptr, nullptr, lane);
}

constexpr int LATE_ITEMS = 3 * 32 * 88 + 3 * 32 * 32;
__device__ __forceinline__ void late_transposes(const Args& a, unsigned char* lds_, int first, int last, int wslot, int nslots) {
    const int lane = threadIdx.x & 63, wave = threadIdx.x >> 6;
    LAS float* scr = (LAS float*)((LAS unsigned char*)lds_ + wave * 16640);
    constexpr int I_GU = 32 * 88;
    for (int it = first + wslot; it < last; it += nslots) {
        int r = it;
        if (r < I_GU) { tr_mat<1>(r, a.in[I_WG], DFF, DFF, (bf16_t*)(a.ws + WS_WGU), DM, scr, lane); continue; } r -= I_GU;
        if (r < I_GU) { tr_mat<2>(r, a.in[I_WU], DFF, DFF, (bf16_t*)(a.ws + WS_WGU), DM, scr, lane); continue; } r -= I_GU;
        if (r < I_GU) { tr_mat<0>(r, a.in[I_WD], DM, DM, (bf16_t*)(a.ws + WS_WD), DFF, scr, lane); continue; } r -= I_GU;
        if (r < 1024) { tr_mat<0>(r, a.in[I_WOUT], DM, DM, (bf16_t*)(a.ws + WS_WOUT), DM, scr, lane); continue; } r -= 1024;
        if (r < 1024) { tr_mat<0>(r, a.in[I_WQ], DM, DM, (bf16_t*)(a.ws + WS_WQ), DM, scr, lane); continue; } r -= 1024;
        tr_mat<0>(r, a.in[I_WO], DM, DM, (bf16_t*)(a.ws + WS_WO), DM, scr, lane);
    }
}

__device__ __forceinline__ void unpack8(const u32x4 w, float* f) { f[0] = bflo(w.x); f[1] = bfhi(w.x); f[2] = bflo(w.y); f[3] = bfhi(w.y); f[4] = bflo(w.z); f[5] = bfhi(w.z); f[6] = bflo(w.w); f[7] = bfhi(w.w); }

__device__ __forceinline__ void rg_item(const Args& a, unsigned char* lds_, int b, int blk, int seg) {
    const int tid = threadIdx.x, lane = tid & 63, wave = tid >> 6;
    unsigned char* ws = a.ws;
    const bf16_t* Z = (const bf16_t*)(ws + WS_Z); float* YPRE = (float*)(ws + WS_YPRE); float* CPRE = (float*)(ws + WS_CPRE); float* RGE = (float*)(ws + WS_RGE);
    bf16_t* XRb = (bf16_t*)lds_;
    float* XRf = (float*)(lds_ + 17408);
    float* Gs = (float*)(lds_ + 17408 + 32768);
    bf16x8 bfr[2][4];
    { const bf16_t* wrg = (const bf16_t*)(ws + WS_WRG) + blk * 32768;
#pragma unroll
      for (int nt = 0; nt < 2; ++nt)
#pragma unroll
          for (int ks = 0; ks < 4; ++ks) bfr[nt][ks] = *(const bf16x8*)(wrg + (wave * 32 + nt * 16 + (lane & 15)) * 128 + ks * 32 + (lane >> 4) * 8); }
    const int c8 = tid & 15, chb = blk * 128 + c8 * 8;
    float cw[4][8], cb[8];
#pragma unroll
    for (int e = 0; e < 8; ++e) { cb[e] = a.in[I_CONVB][chb + e];
#pragma unroll
        for (int j = 0; j < 4; ++j) cw[j][e] = a.in[I_CONVW][j * 1024 + chb + e]; }
    float bias[2];
#pragma unroll
    for (int nt = 0; nt < 2; ++nt) { const int col = wave * 32 + nt * 16 + (lane & 15); bias[nt] = col < 128 ? a.in[I_BRGA][blk * 128 + col] : a.in[I_BRGX][blk * 128 + col - 128]; }
    const int cc = tid & 127;
    float sp; { const float nl = -a.in[I_LAM][blk * 128 + cc]; sp = nl > 20.f ? nl : log1pf(__expf(nl)); }
    float hcar = 0.f, pcar = 1.f;
    u32x4 zpre[2][4];
    { const int t0 = seg * 512;
#pragma unroll
      for (int i = 0; i < 2; ++i)
#pragma unroll
          for (int j = 0; j < 4; ++j) { const int tt = t0 + ((tid + 512 * i) >> 4) - 3 + j; zpre[i][j] = tt >= 0 ? *(const u32x4*)(Z + ((size_t)b * SEQ + tt) * ZW + chb) : (u32x4){0u, 0u, 0u, 0u}; } }
    for (int tile = 0; tile < 8; ++tile) {
        const int t0 = seg * 512 + tile * 64; const size_t R0 = (size_t)b * SEQ + t0;
#pragma unroll
        for (int i = 0; i < 2; ++i) { const int t = (tid + 512 * i) >> 4; float xr[8];
#pragma unroll
            for (int e = 0; e < 8; ++e) xr[e] = cb[e];
#pragma unroll
            for (int j = 0; j < 4; ++j) { float z[8]; unpack8(zpre[i][j], z);
#pragma unroll
                for (int e = 0; e < 8; ++e) xr[e] += cw[j][e] * z[e]; }
            *(f32x4*)(XRf + t * 128 + c8 * 8) = (f32x4){xr[0], xr[1], xr[2], xr[3]}; *(f32x4*)(XRf + t * 128 + c8 * 8 + 4) = (f32x4){xr[4], xr[5], xr[6], xr[7]};
            u32x4 w; w.x = cvt_pk_bf16(xr[0], xr[1]); w.y = cvt_pk_bf16(xr[2], xr[3]); w.z = cvt_pk_bf16(xr[4], xr[5]); w.w = cvt_pk_bf16(xr[6], xr[7]);
            *(u32x4*)(XRb + t * 136 + c8 * 8) = w; }
        if (tile < 7) {
#pragma unroll
            for (int i = 0; i < 2; ++i)
#pragma unroll
                for (int j = 0; j < 4; ++j) { const int tt = t0 + 64 + ((tid + 512 * i) >> 4) - 3 + j; zpre[i][j] = *(const u32x4*)(Z + ((size_t)b * SEQ + tt) * ZW + chb); } }
        LBAR();
        { f32x4 acc[4][2];
#pragma unroll
          for (int mt = 0; mt < 4; ++mt)
#pragma unroll
              for (int nt = 0; nt < 2; ++nt) acc[mt][nt] = (f32x4){0.f, 0.f, 0.f, 0.f};
#pragma unroll
          for (int mt = 0; mt < 4; ++mt)
#pragma unroll
              for (int ks = 0; ks < 4; ++ks) { const bf16x8 af = *(const bf16x8*)(XRb + (mt * 16 + (lane & 15)) * 136 + ks * 32 + (lane >> 4) * 8);
#pragma unroll
                  for (int nt = 0; nt < 2; ++nt) acc[mt][nt] = __builtin_amdgcn_mfma_f32_16x16x32_bf16(af, bfr[nt][ks], acc[mt][nt], 0, 0, 0); }
#pragma unroll
          for (int mt = 0; mt < 4; ++mt)
#pragma unroll
              for (int nt = 0; nt < 2; ++nt)
#pragma unroll
                  for (int j = 0; j < 4; ++j) Gs[(mt * 16 + (lane >> 4) * 4 + j) * 256 + wave * 32 + nt * 16 + (lane & 15)] = sigmoidf_(acc[mt][nt][j] + bias[nt]); }
        LBAR();
#pragma unroll 4
        for (int i = 0; i < 16; ++i) { const int t = (tid + 512 * i) >> 7; const float r = Gs[t * 256 + cc], ig = Gs[t * 256 + 128 + cc];
            const float la = -8.f * r * sp, av = __expf(la), mult = sqrtf(fmaxf(1.f - __expf(2.f * la), 0.f));
            Gs[t * 256 + cc] = av; Gs[t * 256 + 128 + cc] = mult * ig * XRf[t * 128 + cc]; }
        LBAR();
        if (tid < 128) {
#pragma unroll 8
            for (int t = 0; t < 64; ++t) { const float av = Gs[t * 256 + tid]; hcar = av * hcar + Gs[t * 256 + 128 + tid]; pcar *= av; Gs[t * 256 + tid] = hcar; Gs[t * 256 + 128 + tid] = pcar; } }
        LBAR();
#pragma unroll
        for (int i = 0; i < 2; ++i) { const int t = (tid + 512 * i) >> 4; const float* gp = Gs + t * 256 + c8 * 8;
            float* yp = YPRE + (R0 + t) * 1024 + chb; *(f32x4*)yp = *(const f32x4*)gp; *(f32x4*)(yp + 4) = *(const f32x4*)(gp + 4);
            float* pp = CPRE + (R0 + t) * 1024 + chb; *(f32x4*)pp = *(const f32x4*)(gp + 128); *(f32x4*)(pp + 4) = *(const f32x4*)(gp + 132); }
    }
    if (tid < 128) { RGE[((size_t)(b * 4 + seg) * 2 + 0) * 1024 + blk * 128 + tid] = hcar; RGE[((size_t)(b * 4 + seg) * 2 + 1) * 1024 + blk * 128 + tid] = pcar; }
    if (seg == 3 && tid < 384) { const int j = tid >> 7, c = tid & 127; a.out[O_PRGC + ((size_t)b * 3 + j) * 1024 + blk * 128 + c] = bf2f(Z[((size_t)b * SEQ + 2045 + j) * ZW + blk * 128 + c]); }
    __syncthreads();
}

__device__ __forceinline__ void ml_item(const Args& a, unsigned char* lds_, int b, int h, int sl, int seg) {
    const int tid = threadIdx.x, lane = tid & 63, wave = tid >> 6, l15 = lane & 15, lq = lane >> 4;
    unsigned char* ws = a.ws;
    const bf16_t* Z = (const bf16_t*)(ws + WS_Z); const float* GATES = (const float*)(ws + WS_GATES); float* HPRE = (float*)(ws + WS_HPRE); float* MLS = (float*)(ws + WS_MLS);
    bf16_t* Qs = (bf16_t*)lds_;
    bf16_t* Ks = (bf16_t*)(lds_ + 17408);
    bf16_t* Vt = (bf16_t*)(lds_ + 34816);
    bf16_t* Kwt = (bf16_t*)(lds_ + 46336);
    bf16_t* Ss = (bf16_t*)(lds_ + 64768);
    bf16_t* Ctb = (bf16_t*)(lds_ + 73984);
    float* Out = (float*)(lds_ + 95744);
    float* Aa = (float*)(lds_ + 116480);
    float* Am = Aa + 2048;
    float* Bc = Am + 2048;
    const float scale = 0.08838834764831845f;
    for (int i = tid; i < 80 * 136; i += 512) Ctb[i] = 0;
    for (int i = tid; i < 16 * 72; i += 512) Vt[64 * 72 + i] = (i < 72) ? (bf16_t)0x3F80 : (bf16_t)0;
    { const float bi = a.in[I_BMLI][h], bff = a.in[I_BMLF][h];
#pragma unroll
      for (int cI = 0; cI < 4; ++cI) { const int tok = (wave + 8 * cI) * 64 + lane; const size_t R = (size_t)b * SEQ + tok;
          const float gi = GATES[R * 8 + h] + bi, gf = GATES[R * 8 + 4 + h] + bff;
          const float lf = fminf(gf, 0.f) - log1pf(__expf(-fabsf(gf)));
          float bc = lf;
#pragma unroll
          for (int o = 1; o < 64; o <<= 1) { const float t = __shfl_up(bc, o); if (lane >= o) bc += t; }
          const float av = gi - bc; float am = av;
#pragma unroll
          for (int o = 1; o < 64; o <<= 1) { const float t = __shfl_up(am, o); if (lane >= o) am = fmaxf(am, t); }
          Aa[tok] = av; Am[tok] = am; Bc[tok] = bc; } }
    f32x4 cacc[5];
#pragma unroll
    for (int mt = 0; mt < 5; ++mt) cacc[mt] = (f32x4){0.f, 0.f, 0.f, 0.f};
    float m_prev = 0.f, m_old = 0.f, m_seg = 0.f, Fs = 0.f, Fs_old = 0.f;
    const int pt = tid & 63, pd8 = tid >> 6;
    u32x4 qpre[2], kpre[2], vpre;
#define ML_LOAD(Q, K, V, R0_) do { _Pragma("unroll") for (int i = 0; i < 2; ++i) { Q[i] = *(const u32x4*)(Z + ((R0_) + pt) * ZW + 2048 + h * 128 + (2 * pd8 + i) * 8); K[i] = *(const u32x4*)(Z + ((R0_) + pt) * ZW + 2560 + h * 128 + (2 * pd8 + i) * 8); } \
        V = *(const u32x4*)(Z + ((R0_) + pt) * ZW + 3072 + h * 256 + sl * 64 + pd8 * 8); } while (0)
    { const size_t R0 = (size_t)b * SEQ + seg * 1024; ML_LOAD(qpre, kpre, vpre, R0); }
    __syncthreads();
    for (int c = 0; c < seg * 16; ++c) m_prev = Bc[c * 64 + 63] + fmaxf(m_prev, Am[c * 64 + 63]);
    m_seg = m_prev; m_old = m_prev;
#pragma unroll 1
    for (int ci = 0; ci <= 16; ++ci) {
        const int ch = seg * 16 + ci, c0 = ch * 64;
        const int cq = ci < 16 ? c0 : 0; const float F = Bc[cq + 63], m_new = F + fmaxf(m_prev, Am[cq + 63]), dec = __expf(F + m_prev - m_new);
        if (ci < 16) { const float wend = __expf(F + Aa[c0 + pt] - m_new) * scale;
#pragma unroll
          for (int i = 0; i < 2; ++i) { const int d8 = 2 * pd8 + i;
              *(u32x4*)(Qs + pt * 136 + d8 * 8) = qpre[i]; *(u32x4*)(Ks + pt * 136 + d8 * 8) = kpre[i];
              float kf[8]; unpack8(kpre[i], kf); bf16_t* kp = Kwt + (d8 * 8) * 72 + pt;
#pragma unroll
              for (int e = 0; e < 8; ++e) kp[e * 72] = f2bf(kf[e] * wend); }
          bf16_t* vp = Vt + (pd8 * 8) * 72 + pt; const u32x4 w = vpre;
          vp[0] = (bf16_t)(w.x & 0xffff); vp[72] = (bf16_t)(w.x >> 16); vp[144] = (bf16_t)(w.y & 0xffff); vp[216] = (bf16_t)(w.y >> 16);
          vp[288] = (bf16_t)(w.z & 0xffff); vp[360] = (bf16_t)(w.z >> 16); vp[432] = (bf16_t)(w.w & 0xffff); vp[504] = (bf16_t)(w.w >> 16); }
        if (ci > 0) { const size_t R1 = (size_t)b * SEQ + c0 - 64;
#pragma unroll
            for (int mt = 0; mt < 5; ++mt)
#pragma unroll
                for (int j = 0; j < 4; ++j) Ctb[(mt * 16 + lq * 4 + j) * 136 + wave * 16 + l15] = f2bf(cacc[mt][j]);
#pragma unroll
            for (int i = 0; i < 8; ++i) { const int idx = tid + 512 * i, v = idx & 63, t = idx >> 6; HPRE[(R1 + t) * 1024 + h * 256 + sl * 64 + v] = Out[t * 81 + v]; }
            if (sl == 0 && tid < 64) { const int t = tid; const float mtv = Bc[c0 - 64 + t] + fmaxf(m_old, Am[c0 - 64 + t]);
                f32x4 o; o[0] = Out[t * 81 + 64]; o[1] = __expf(-mtv); o[2] = seg ? __expf(Fs_old + Bc[c0 - 64 + t] + m_seg - mtv) : 0.f; o[3] = 0.f;
                *(f32x4*)(MLS + ((R1 + t) * 4 + h) * 4) = o; } }
        if (ci == 16) break;
        if (ci < 15) { const size_t R0 = (size_t)b * SEQ + c0 + 64; ML_LOAD(qpre, kpre, vpre, R0); }
        LBAR();
        { const int mt = wave >> 1; bf16x8 afq[4]; f32x4 acc2[2] = {{0.f, 0.f, 0.f, 0.f}, {0.f, 0.f, 0.f, 0.f}};
#pragma unroll
          for (int ks = 0; ks < 4; ++ks) afq[ks] = *(const bf16x8*)(Qs + (mt * 16 + l15) * 136 + ks * 32 + lq * 8);
#pragma unroll
          for (int ks = 0; ks < 4; ++ks)
#pragma unroll
              for (int n = 0; n < 2; ++n) { const int nt = 2 * (wave & 1) + n; const bf16x8 bfv = *(const bf16x8*)(Ks + (nt * 16 + l15) * 136 + ks * 32 + lq * 8);
                  acc2[n] = __builtin_amdgcn_mfma_f32_16x16x32_bf16(afq[ks], bfv, acc2[n], 0, 0, 0); }
#pragma unroll
          for (int n = 0; n < 2; ++n) { const int nt = 2 * (wave & 1) + n; const int sI = nt * 16 + l15; const float as = Aa[c0 + sI];
#pragma unroll
              for (int j = 0; j < 4; ++j) { const int t = mt * 16 + lq * 4 + j; const float v = (sI <= t) ? acc2[n][j] * scale * __expf(as - fmaxf(m_prev, Am[c0 + t])) : 0.f; Ss[t * 72 + sI] = f2bf(v); } } }
        LBAR();
        { const int mt = wave & 3, nt0 = wave < 4 ? 0 : 3, nn = wave < 4 ? 3 : 2; bf16x8 afq[4], afs[2]; f32x4 acc3[3];
#pragma unroll
          for (int n = 0; n < 3; ++n) acc3[n] = (f32x4){0.f, 0.f, 0.f, 0.f};
#pragma unroll
          for (int ks = 0; ks < 4; ++ks) afq[ks] = *(const bf16x8*)(Qs + (mt * 16 + l15) * 136 + ks * 32 + lq * 8);
#pragma unroll
          for (int ks = 0; ks < 2; ++ks) afs[ks] = *(const bf16x8*)(Ss + (mt * 16 + l15) * 72 + ks * 32 + lq * 8);
#pragma unroll
          for (int ks = 0; ks < 4; ++ks)
#pragma unroll
              for (int n = 0; n < 3; ++n) if (n < nn) { const bf16x8 bfv = *(const bf16x8*)(Ctb + ((nt0 + n) * 16 + l15) * 136 + ks * 32 + lq * 8);
                  acc3[n] = __builtin_amdgcn_mfma_f32_16x16x32_bf16(afq[ks], bfv, acc3[n], 0, 0, 0); }
          float scv[4];
#pragma unroll
          for (int j = 0; j < 4; ++j) scv[j] = __expf(m_prev - fmaxf(m_prev, Am[c0 + mt * 16 + lq * 4 + j]));
#pragma unroll
          for (int n = 0; n < 3; ++n)
#pragma unroll
              for (int j = 0; j < 4; ++j) acc3[n][j] *= scv[j];
#pragma unroll
          for (int ks = 0; ks < 2; ++ks)
#pragma unroll
              for (int n = 0; n < 3; ++n) if (n < nn) { const bf16x8 bfv = *(const bf16x8*)(Vt + ((nt0 + n) * 16 + l15) * 72 + ks * 32 + lq * 8);
                  acc3[n] = __builtin_amdgcn_mfma_f32_16x16x32_bf16(afs[ks], bfv, acc3[n], 0, 0, 0); }
#pragma unroll
          for (int n = 0; n < 3; ++n) if (n < nn) {
#pragma unroll
              for (int j = 0; j < 4; ++j) Out[(mt * 16 + lq * 4 + j) * 81 + (nt0 + n) * 16 + l15] = acc3[n][j]; } }
#pragma unroll
        for (int mt = 0; mt < 5; ++mt) { cacc[mt] = cacc[mt] * dec;
#pragma unroll
            for (int ks = 0; ks < 2; ++ks) { const bf16x8 af = *(const bf16x8*)(Vt + (mt * 16 + l15) * 72 + ks * 32 + lq * 8), bfv = *(const bf16x8*)(Kwt + (wave * 16 + l15) * 72 + ks * 32 + lq * 8);
                cacc[mt] = __builtin_amdgcn_mfma_f32_16x16x32_bf16(af, bfv, cacc[mt], 0, 0, 0); } }
        m_old = m_prev; m_prev = m_new; Fs_old = Fs; Fs += F;
        LBAR();
    }
#undef ML_LOAD
    if (seg == 0) {
        float* CINF = (float*)(ws + WS_CINF) + (size_t)((b * 4 + h) * 4 + sl) * 80 * 128; bf16_t* CIN = (bf16_t*)(ws + WS_CIN) + (size_t)((b * 4 + h) * 4 + sl) * 80 * 128;
#pragma unroll
        for (int mt = 0; mt < 5; ++mt)
#pragma unroll
            for (int j = 0; j < 4; ++j) { const int o = (mt * 16 + lq * 4 + j) * 128 + wave * 16 + l15; CINF[o] = cacc[mt][j]; CIN[o] = f2bf(cacc[mt][j]); }
    } else {
#pragma unroll
        for (int mt = 0; mt < 4; ++mt)
#pragma unroll
            for (int j = 0; j < 4; ++j) a.out[O_PMLC + ((size_t)((b * 4 + h) * 128 + wave * 16 + l15)) * 256 + sl * 64 + mt * 16 + lq * 4 + j] = cacc[mt][j];
        if (sl == 0) { if (lq == 0) a.out[O_PMLN + (size_t)(b * 4 + h) * 128 + wave * 16 + l15] = cacc[4][0];
            if (tid == 0) { a.out[O_PMLM + b * 4 + h] = m_prev; ((float*)(ws + WS_GL))[b * 4 + h] = __expf(Fs + m_seg - m_prev); } }
    }
    __syncthreads();
}

__device__ __forceinline__ void sample_item(const Args& a, unsigned char* lds_, int b) {
    const int tid = threadIdx.x, lane = tid & 63, wave = tid >> 6;
    unsigned char* ws = a.ws;
    const size_t r = (size_t)NP + b;
    const bf16_t* Zr = (const bf16_t*)(ws + WS_Z) + r * ZW; const float* GATES = (const float*)(ws + WS_GATES) + r * 8;
    float* YPRE = (float*)(ws + WS_YPRE) + r * 1024; float* HPRE = (float*)(ws + WS_HPRE) + r * 1024;
    float* xr = (float*)lds_;
    float* gpre = xr + 1024;
    float* qs = gpre + 2048;
    float* ks = qs + 128;
    float* vs = ks + 128;
    float* red = vs + 256;
    float* dn = red + 2048;
#pragma unroll
    for (int i = 0; i < 2; ++i) { const int c = tid + 512 * i; const float zx = bf2f(Zr[c]);
        const float b0 = a.in[I_SRGC][((size_t)b * 3 + 0) * 1024 + c], b1 = a.in[I_SRGC][((size_t)b * 3 + 1) * 1024 + c], b2 = a.in[I_SRGC][((size_t)b * 3 + 2) * 1024 + c];
        xr[c] = a.in[I_CONVB][c] + a.in[I_CONVW][c] * b0 + a.in[I_CONVW][1024 + c] * b1 + a.in[I_CONVW][2048 + c] * b2 + a.in[I_CONVW][3072 + c] * zx;
        a.out[O_SRGC + ((size_t)b * 3 + 0) * 1024 + c] = b1; a.out[O_SRGC + ((size_t)b * 3 + 1) * 1024 + c] = b2; a.out[O_SRGC + ((size_t)b * 3 + 2) * 1024 + c] = zx; }
    __syncthreads();
    { const int mat = tid >> 8, q = tid & 255, blk = q >> 5, d4 = (q & 31) * 4;
      const float* W = (mat ? a.in[I_WRGX] : a.in[I_WRGA]) + blk * 16384 + d4; const float* xb = xr + blk * 128;
      f32x4 acc = *(const f32x4*)((mat ? a.in[I_BRGX] : a.in[I_BRGA]) + blk * 128 + d4);
#pragma unroll 1
      for (int k0 = 0; k0 < 128; k0 += 16) { f32x4 w[16];
#pragma unroll
          for (int k = 0; k < 16; ++k) w[k] = *(const f32x4*)(W + (size_t)(k0 + k) * 128);
#pragma unroll
          for (int k = 0; k < 16; ++k) acc += w[k] * xb[k0 + k]; }
      *(f32x4*)(gpre + mat * 1024 + blk * 128 + d4) = acc; }
    __syncthreads();
#pragma unroll
    for (int i = 0; i < 2; ++i) { const int c = tid + 512 * i;
        const float rg = sigmoidf_(gpre[c]), ig = sigmoidf_(gpre[1024 + c]); const float nl = -a.in[I_LAM][c]; const float sp = nl > 20.f ? nl : log1pf(__expf(nl));
        const float la = -8.f * rg * sp, av = __expf(la), mult = sqrtf(fmaxf(1.f - __expf(2.f * la), 0.f));
        const float hv = av * a.in[I_SRGH][(size_t)b * 1024 + c] + mult * (ig * xr[c]);
        a.out[O_SRGH + (size_t)b * 1024 + c] = hv; YPRE[c] = hv * gelu_tanh(bf2f(Zr[1024 + c])); }
    for (int h = 0; h < 4; ++h) {
        const float* C0 = a.in[I_SMLC] + (size_t)(b * 4 + h) * 128 * 256; float* C1 = a.out + O_SMLC + (size_t)(b * 4 + h) * 128 * 256;
        f32x4 c0[16];
#pragma unroll
        for (int i = 0; i < 16; ++i) c0[i] = *(const f32x4*)(C0 + (size_t)(wave + 8 * i) * 256 + 4 * lane);
        __syncthreads();
        if (tid < 128) { qs[tid] = bf2f(Zr[2048 + h * 128 + tid]); ks[tid] = bf2f(Zr[2560 + h * 128 + tid]) * 0.08838834764831845f; }
        else if (tid < 384) vs[tid - 128] = bf2f(Zr[3072 + h * 256 + tid - 128]);
        const float li = GATES[h] + a.in[I_BMLI][h], gf = GATES[4 + h] + a.in[I_BMLF][h]; const float lf = fminf(gf, 0.f) - log1pf(__expf(-fabsf(gf)));
        const float m0 = a.in[I_SMLM][b * 4 + h]; const float m_new = fmaxf(lf + m0, li), sc = __expf(lf + m0 - m_new), Dv = __expf(li - m_new);
        __syncthreads();
        f32x4 num = {0.f, 0.f, 0.f, 0.f}; const f32x4 v4 = *(const f32x4*)(vs + 4 * lane);
#pragma unroll
        for (int i = 0; i < 16; ++i) { const int d = wave + 8 * i; const f32x4 cn = c0[i] * sc + v4 * (Dv * ks[d]);
            *(f32x4*)(C1 + (size_t)d * 256 + 4 * lane) = cn; num += cn * qs[d]; }
        *(f32x4*)(red + wave * 256 + 4 * lane) = num;
        if (tid < 128) { const float nn = sc * a.in[I_SMLN][(size_t)(b * 4 + h) * 128 + tid] + Dv * ks[tid]; a.out[O_SMLN + (size_t)(b * 4 + h) * 128 + tid] = nn; dn[tid] = nn * qs[tid]; }
        if (tid == 0) a.out[O_SMLM + b * 4 + h] = m_new;
        __syncthreads();
        if (tid < 256) { float den = 0.f;
#pragma unroll 8
            for (int k = 0; k < 128; ++k) den += dn[k];
            den = fmaxf(fabsf(den), __expf(-m_new)); float nv = 0.f;
#pragma unroll
            for (int w = 0; w < 8; ++w) nv += red[w * 256 + tid];
            HPRE[h * 256 + tid] = nv / den; }
    }
    __syncthreads();
}

__device__ __forceinline__ void fin_row(const Args& a, int r, const float* hin, int lane, bool mlnorm) {
    unsigned char* ws = a.ws; const bf16_t* Z = (const bf16_t*)(ws + WS_Z); const float* YPRE = (const float*)(ws + WS_YPRE); const float* CPRE = (const float*)(ws + WS_CPRE);
    const float* HPRE = (const float*)(ws + WS_HPRE); bf16_t* YMIX = (bf16_t*)(ws + WS_YMIX);
    f32x4 y[4]; float ss = 0.f;
#pragma unroll
    for (int j = 0; j < 4; ++j) { y[j] = *(const f32x4*)(YPRE + (size_t)r * 1024 + 4 * lane + 256 * j);
        if (hin) { const f32x4 p = *(const f32x4*)(CPRE + (size_t)r * 1024 + 4 * lane + 256 * j), hi = *(const f32x4*)(hin + 4 * lane + 256 * j);
            const u32x2 zg = *(const u32x2*)(Z + (size_t)r * ZW + 1024 + 4 * lane + 256 * j); y[j] = y[j] + p * hi;
            y[j][0] *= gelu_tanh(bflo(zg.x)); y[j][1] *= gelu_tanh(bfhi(zg.x)); y[j][2] *= gelu_tanh(bflo(zg.y)); y[j][3] *= gelu_tanh(bfhi(zg.y)); }
        ss += (y[j][0] * y[j][0] + y[j][1] * y[j][1]) + (y[j][2] * y[j][2] + y[j][3] * y[j][3]); }
    ss = wave_sum(ss); const float rs = rsqrtf(ss * (1.f / 1024.f) + EPS);
#pragma unroll
    for (int j = 0; j < 4; ++j) { const f32x4 gg = *(const f32x4*)(a.in[I_GRG] + 4 * lane + 256 * j); const f32x4 o = y[j] * rs * gg;
        u32x2 w; w.x = cvt_pk_bf16(o[0], o[1]); w.y = cvt_pk_bf16(o[2], o[3]); *(u32x2*)(YMIX + (size_t)r * DM + 4 * lane + 256 * j) = w; }
#pragma unroll
    for (int j = 0; j < 4; ++j) { f32x4 hv = *(const f32x4*)(HPRE + (size_t)r * 1024 + j * 256 + 4 * lane);
        if (mlnorm) { const f32x4 ms = *(const f32x4*)((const float*)(ws + WS_MLS) + ((size_t)r * 4 + j) * 4); hv = hv * (1.f / fmaxf(fabsf(ms[0]), ms[1])); }
        const float s2 = wave_sum((hv[0] * hv[0] + hv[1] * hv[1]) + (hv[2] * hv[2] + hv[3] * hv[3])); const float r2 = rsqrtf(s2 * (1.f / 256.f) + EPS);
        const f32x4 gg = *(const f32x4*)(a.in[I_GML] + j * 256 + 4 * lane); const u32x2 zo = *(const u32x2*)(Z + (size_t)r * ZW + 4096 + j * 256 + 4 * lane);
        f32x4 o = hv * r2 * gg; o[0] *= sigmoidf_(bflo(zo.x)); o[1] *= sigmoidf_(bfhi(zo.x)); o[2] *= sigmoidf_(bflo(zo.y)); o[3] *= sigmoidf_(bfhi(zo.y));
        u32x2 w; w.x = cvt_pk_bf16(o[0], o[1]); w.y = cvt_pk_bf16(o[2], o[3]); *(u32x2*)(YMIX + (size_t)r * DM + 1024 + j * 256 + 4 * lane) = w; }
}
__device__ __forceinline__ void phase_finalize(const Args& a, unsigned char* lds_, int G) {
    const int tid = threadIdx.x, lane = tid & 63, wave = tid >> 6;
    const float* RGE = (const float*)(a.ws + WS_RGE); float* hin = (float*)lds_;
    for (int g = blockIdx.x; g < 256; g += G) {
        const int b = g >> 6, seg = (g >> 4) & 3;
        for (int c = tid; c < 1024; c += 512) { float hh = 0.f;
            for (int q = 0; q < seg; ++q) hh = RGE[((size_t)(b * 4 + q) * 2 + 0) * 1024 + c] + RGE[((size_t)(b * 4 + q) * 2 + 1) * 1024 + c] * hh;
            hin[c] = hh;
            if ((g & 63) == 63) a.out[O_PRGH + (size_t)b * 1024 + c] = RGE[((size_t)(b * 4 + 3) * 2 + 0) * 1024 + c] + RGE[((size_t)(b * 4 + 3) * 2 + 1) * 1024 + c] * hh; }
        if ((g & 63) >= 32) {
            const int hh = wave >> 1, mt = wave & 1, l15 = lane & 15, lq = lane >> 4, r0 = g * 32;
            const bf16_t* Z = (const bf16_t*)(a.ws + WS_Z); float* HPRE = (float*)(a.ws + WS_HPRE); float* MLS = (float*)(a.ws + WS_MLS);
            bf16x8 afq[4]; float gj[4];
#pragma unroll
            for (int ks = 0; ks < 4; ++ks) afq[ks] = *(const bf16x8*)(Z + (size_t)(r0 + mt * 16 + l15) * ZW + 2048 + hh * 128 + ks * 32 + lq * 8);
#pragma unroll
            for (int j = 0; j < 4; ++j) gj[j] = MLS[((size_t)(r0 + mt * 16 + lq * 4 + j) * 4 + hh) * 4 + 2];
            float* hp = HPRE + (size_t)(r0 + mt * 16 + lq * 4) * 1024 + hh * 256 + l15;
#pragma unroll 1
            for (int sl = 0; sl < 4; ++sl) { const bf16_t* cin = (const bf16_t*)(a.ws + WS_CIN) + (size_t)((b * 4 + hh) * 4 + sl) * 80 * 128;
                float old[4][4]; f32x4 acc[4];
#pragma unroll
                for (int nt = 0; nt < 4; ++nt)
#pragma unroll
                    for (int j = 0; j < 4; ++j) old[nt][j] = hp[(size_t)j * 1024 + sl * 64 + nt * 16];
#pragma unroll
                for (int nt = 0; nt < 4; ++nt) { acc[nt] = (f32x4){0.f, 0.f, 0.f, 0.f};
#pragma unroll
                    for (int ks = 0; ks < 4; ++ks) { const bf16x8 bfv = *(const bf16x8*)(cin + (nt * 16 + l15) * 128 + ks * 32 + lq * 8); acc[nt] = __builtin_amdgcn_mfma_f32_16x16x32_bf16(afq[ks], bfv, acc[nt], 0, 0, 0); } }
#pragma unroll
                for (int nt = 0; nt < 4; ++nt)
#pragma unroll
                    for (int j = 0; j < 4; ++j) hp[(size_t)j * 1024 + sl * 64 + nt * 16] = old[nt][j] + gj[j] * acc[nt][j];
                if (sl == 0) { f32x4 an = {0.f, 0.f, 0.f, 0.f};
#pragma unroll
                    for (int ks = 0; ks < 4; ++ks) { const bf16x8 bfv = *(const bf16x8*)(cin + (64 + l15) * 128 + ks * 32 + lq * 8); an = __builtin_amdgcn_mfma_f32_16x16x32_bf16(afq[ks], bfv, an, 0, 0, 0); }
                    if (l15 == 0) {
#pragma unroll
                        for (int j = 0; j < 4; ++j) MLS[((size_t)(r0 + mt * 16 + lq * 4 + j) * 4 + hh) * 4] += gj[j] * an[j]; } } }
        }
        __syncthreads();
        for (int rr = wave; rr < 32; rr += 8) fin_row(a, g * 32 + rr, hin, lane, true);
        __syncthreads();
    }
    {
        const float* CINF = (const float*)(a.ws + WS_CINF); const float* GL = (const float*)(a.ws + WS_GL);
        for (int idx = blockIdx.x * 512 + tid; idx < 16 * 128 * 256; idx += G * 512) { const int bh = idx >> 15, d = (idx >> 8) & 127, v = idx & 255;
            a.out[O_PMLC + idx] += GL[bh] * CINF[((size_t)(bh * 4 + (v >> 6)) * 80 + (v & 63)) * 128 + d]; }
        for (int idx = blockIdx.x * 512 + tid; idx < 16 * 128; idx += G * 512) { const int bh = idx >> 7, d = idx & 127;
            a.out[O_PMLN + idx] += GL[bh] * CINF[((size_t)(bh * 4) * 80 + 64) * 128 + d]; }
    }
    for (int j = blockIdx.x; j < NS; j += G) {
        if (wave == 0) fin_row(a, NP + j, nullptr, lane, false);
        if (wave == 1) {
#pragma unroll
            for (int q = 0; q < 8; ++q) *(u32x2*)((bf16_t*)(a.ws + WS_YMIX) + (size_t)(MV + j) * DM + 4 * lane + 256 * q) = (u32x2){0u, 0u}; }
    }
}

__device__ __forceinline__ void sattn_item(const Args& a, unsigned char* lds_, int b, int h) {
    const int tid = threadIdx.x, lane = tid & 63, wave = tid >> 6;
    unsigned char* ws = a.ws;
    float* SC = (float*)lds_;
    float* RED = SC + 1024;
    float q[8];
    { f32x4 q0 = {0.f, 0.f, 0.f, 0.f}, q1 = {0.f, 0.f, 0.f, 0.f}; const float* qp = (const float*)(ws + WS_P4) + (size_t)b * DM + h * 512 + lane * 8;
#pragma unroll
      for (int k = 0; k < 8; ++k) { q0 += *(const f32x4*)(qp + (size_t)k * NS * DM); q1 += *(const f32x4*)(qp + (size_t)k * NS * DM + 4); }
#pragma unroll
      for (int e = 0; e < 4; ++e) { q[e] = q0[e] * 0.04419417382415922f; q[4 + e] = q1[e] * 0.04419417382415922f; } }
    const float* kb = a.in[I_CK] + ((size_t)b * NMEM * 4 + h) * 512 + lane * 8; const float* vb = a.in[I_CV] + ((size_t)b * NMEM * 4 + h) * 512 + lane * 8;
    float mys = 0.f;
#pragma unroll 8
    for (int mm = 0; mm < 32; ++mm) { const float* p = kb + (size_t)(wave * 32 + mm) * DM; const f32x4 k0 = __builtin_nontemporal_load((const f32x4*)p), k1 = __builtin_nontemporal_load((const f32x4*)(p + 4));
        float d = (k0[0] * q[0] + k0[1] * q[1]) + (k0[2] * q[2] + k0[3] * q[3]) + (k1[0] * q[4] + k1[1] * q[5]) + (k1[2] * q[6] + k1[3] * q[7]);
        d = wave_sum(d); if (lane == mm) mys = d; }
    if (lane < 32) SC[wave * 32 + lane] = mys;
    __syncthreads();
    const float s0 = SC[lane], s1 = SC[64 + lane], s2 = SC[128 + lane], s3 = SC[192 + lane];
    const float mx = wave_max(fmaxf(fmaxf(s0, s1), fmaxf(s2, s3)));
    const float tot = wave_sum((__expf(s0 - mx) + __expf(s1 - mx)) + (__expf(s2 - mx) + __expf(s3 - mx)));
    f32x4 o0 = {0.f, 0.f, 0.f, 0.f}, o1 = {0.f, 0.f, 0.f, 0.f};
#pragma unroll 8
    for (int mm = 0; mm < 32; ++mm) { const int m = wave * 32 + mm; const float* p = vb + (size_t)m * DM; const float pr = __expf(SC[m] - mx);
        o0 += pr * __builtin_nontemporal_load((const f32x4*)p); o1 += pr * __builtin_nontemporal_load((const f32x4*)(p + 4)); }
    *(f32x4*)(RED + wave * 512 + lane * 8) = o0; *(f32x4*)(RED + wave * 512 + lane * 8 + 4) = o1;
    __syncthreads();
    { float s = 0.f;
#pragma unroll
      for (int w = 0; w < 8; ++w) s += RED[w * 512 + tid];
      ((bf16_t*)(ws + WS_OB))[((size_t)NP + b) * DM + h * 512 + tid] = f2bf(s / tot); }
    __syncthreads();
}

__device__ __forceinline__ void sample_prep(const float* X, const float* Pp, int nks, const float* g, bf16_t* Aout, float* Xnext, int lane) {
    f32x4 v[8]; float ss = 0.f;
#pragma unroll
    for (int j = 0; j < 8; ++j) { v[j] = *(const f32x4*)(X + 4 * lane + 256 * j);
        for (int k = 0; k < nks; ++k) v[j] += *(const f32x4*)(Pp + (size_t)k * NS * DM + 4 * lane + 256 * j);
        ss += (v[j][0] * v[j][0] + v[j][1] * v[j][1]) + (v[j][2] * v[j][2] + v[j][3] * v[j][3]); }
    ss = wave_sum(ss); const float rs = rsqrtf(ss * (1.f / DM) + EPS);
#pragma unroll
    for (int j = 0; j < 8; ++j) { *(f32x4*)(Xnext + 4 * lane + 256 * j) = v[j]; const f32x4 o = v[j] * rs * *(const f32x4*)(g + 4 * lane + 256 * j);
        u32x2 w; w.x = cvt_pk_bf16(o[0], o[1]); w.y = cvt_pk_bf16(o[2], o[3]); *(u32x2*)(Aout + 4 * lane + 256 * j) = w; }
}
__device__ __forceinline__ void phase_final(const Args& a, int G, bool prompt_done, int row0, int rstride) {
    if (prompt_done) {
        extern __shared__ __attribute__((aligned(16))) unsigned char lds_dyn_[]; float* red8 = (float*)lds_dyn_;
        const int tid_ = threadIdx.x, lane_ = tid_ & 63, wave_ = tid_ >> 6;
        for (int rs_ = row0; rs_ < NS; rs_ += rstride) {
            const float* src = (const float*)(a.ws + WS_X2S) + (size_t)rs_ * DM + wave_ * 256 + 4 * lane_; const float* pp = (const float*)(a.ws + WS_P8) + (size_t)rs_ * DM + wave_ * 256 + 4 * lane_;
            f32x4 v = *(const f32x4*)src; f32x4 p[22];
#pragma unroll
            for (int k = 0; k < 22; ++k) p[k] = *(const f32x4*)(pp + (size_t)k * NS * DM);
#pragma unroll
            for (int k = 0; k < 22; ++k) v += p[k];
            const float ss = wave_sum((v[0] * v[0] + v[1] * v[1]) + (v[2] * v[2] + v[3] * v[3]));
            __syncthreads();
            if (lane_ == 0) red8[wave_] = ss;
            __syncthreads();
            const float tot = ((red8[0] + red8[1]) + (red8[2] + red8[3])) + ((red8[4] + red8[5]) + (red8[6] + red8[7]));
            const float rs = rsqrtf(tot * (1.f / DM) + EPS);
            *(f32x4*)(a.out + O_YS + (size_t)rs_ * DM + wave_ * 256 + 4 * lane_) = v * rs * *(const f32x4*)(a.in[I_GFIN] + wave_ * 256 + 4 * lane_);
        }
        return;
    }
    const int lane = threadIdx.x & 63, wave = threadIdx.x >> 6; const int gw = blockIdx.x * 8 + wave, NGW = G * 8;
    for (int r = prompt_done ? NP + gw : gw; r < MV; r += NGW) { float* p = r < NP ? a.out + O_YP + (size_t)r * DM : a.out + O_YS + (size_t)(r - NP) * DM;
        const float* src = r < NP ? p : (const float*)(a.ws + WS_X2S) + (size_t)(r - NP) * DM;
        f32x4 v[8]; float ss = 0.f;
#pragma unroll
        for (int j = 0; j < 8; ++j) { v[j] = *(const f32x4*)(src + 4 * lane + 256 * j);
            if (r >= NP) { for (int k = 0; k < 22; ++k) v[j] += *(const f32x4*)((const float*)(a.ws + WS_P8) + ((size_t)k * NS + (r - NP)) * DM + 4 * lane + 256 * j); } ss += (v[j][0] * v[j][0] + v[j][1] * v[j][1]) + (v[j][2] * v[j][2] + v[j][3] * v[j][3]); }
        ss = wave_sum(ss); const float rs = rsqrtf(ss * (1.f / DM) + EPS);
#pragma unroll
        for (int j = 0; j < 8; ++j) *(f32x4*)(p + 4 * lane + 256 * j) = v[j] * rs * *(const f32x4*)(a.in[I_GFIN] + 4 * lane + 256 * j); }
}

#define XB_TMO      128
#define XB_XCNT(j)  (256  + 64 * (j))
#define XB_XSUB(j)  (1280 + 64 * (j))
#define XB_XGEN(j)  (2304 + 64 * (j))
#define XB_TOP      3328
#define XB_TOPGEN   3392
#define XCD_BAR_WORDS 3456
#define XB_SPIN_CAP (1u << 18)
__device__ __forceinline__ unsigned xb_ld(unsigned* p)              { return __hip_atomic_load(p, __ATOMIC_RELAXED, __HIP_MEMORY_SCOPE_AGENT); }
__device__ __forceinline__ unsigned xb_add(unsigned* p, unsigned v) { return __hip_atomic_fetch_add(p, v, __ATOMIC_RELAXED, __HIP_MEMORY_SCOPE_AGENT); }
__device__ __forceinline__ unsigned xb_xcc_id() { return (unsigned)__builtin_amdgcn_s_getreg((3 << 11) | 20) & 0xFu; }
#define XB_SPIN(cond, bar) do { unsigned _sp = 0; while (cond) { __builtin_amdgcn_s_sleep(1); \
    if ((++_sp & 255u) == 0u) { if (xb_ld(&(bar)[XB_TMO])) break; if (_sp > XB_SPIN_CAP) { atomicAdd(&(bar)[XB_TMO], 1u); break; } } } } while (0)
struct XcdBarrier { unsigned* bar; unsigned x; volatile LAS unsigned* st; };
__device__ __forceinline__ void xcd_barrier_complete(unsigned* bar, unsigned x, unsigned& nloc, unsigned& nx) {
    const unsigned G = gridDim.x * gridDim.y * gridDim.z;
    unsigned sum, cnt, mine, sp = 0u;
    for (;;) {
        sum = 0u; cnt = 0u; mine = 0u;
#pragma unroll
        for (unsigned j = 0; j < 16; ++j) { const unsigned c = xb_ld(&bar[XB_XCNT(j)]); sum += c; cnt += (c > 0u) ? 1u : 0u; mine = (j == x) ? c : mine; }
        if (sum == G) break;
        __builtin_amdgcn_s_sleep(1);
        if ((++sp & 255u) == 0u) { if (xb_ld(&bar[XB_TMO])) break; if (sp > XB_SPIN_CAP) { atomicAdd(&bar[XB_TMO], 1u); break; } }
    }
    nloc = mine > 0u ? mine : 1u; nx = cnt > 0u ? cnt : 1u;
}
__device__ __forceinline__ void xcd_barrier(const XcdBarrier& b) {
    asm volatile("s_waitcnt vmcnt(0)" ::: "memory");
    __syncthreads();
    if (threadIdx.x == 0) {
        unsigned* bar = b.bar;
        __builtin_amdgcn_s_waitcnt(0);
        unsigned nloc = b.st[0], nx = b.st[1];
        if (nloc == 0u) { xcd_barrier_complete(bar, b.x, nloc, nx); b.st[0] = nloc; b.st[1] = nx; }
        const unsigned old = xb_add(&bar[XB_XSUB(b.x)], 1u);
        const unsigned gen = old / nloc;
        if (old + 1u == (gen + 1u) * nloc) {
            __builtin_amdgcn_fence(__ATOMIC_RELEASE, "agent");
            asm volatile("s_waitcnt vmcnt(0)" ::: "memory");
            const unsigned og = xb_add(&bar[XB_TOP], 1u);
            const unsigned tg = og / nx;
            if (og + 1u == (tg + 1u) * nx) xb_add(&bar[XB_TOPGEN], 1u);
            else XB_SPIN(xb_ld(&bar[XB_TOPGEN]) == tg, bar);
            __builtin_amdgcn_fence(__ATOMIC_ACQUIRE, "agent");
            xb_add(&bar[XB_XGEN(b.x)], 1u);
            asm volatile("s_waitcnt vmcnt(0)" ::: "memory");
        } else {
            XB_SPIN(xb_ld(&bar[XB_XGEN(b.x)]) == gen, bar);
            __builtin_amdgcn_fence(__ATOMIC_ACQUIRE, "agent");
            asm volatile("s_waitcnt vmcnt(0)" ::: "memory");
        }
    }
    __syncthreads();
}

__device__ __forceinline__ void flag_signal(unsigned* flag) {
    asm volatile("s_waitcnt vmcnt(0)" ::: "memory");
    __syncthreads();
    if (threadIdx.x == 0) { __builtin_amdgcn_fence(__ATOMIC_RELEASE, "agent"); asm volatile("s_waitcnt vmcnt(0)" ::: "memory"); (void)xb_add(flag, 1u); }
}
__device__ __forceinline__ void flag_wait(unsigned* flag, unsigned want) {
    if (threadIdx.x == 0) { unsigned sp = 0u; while (xb_ld(flag) < want) { __builtin_amdgcn_s_sleep(2); if (++sp > (1u << 20)) break; }
        __builtin_amdgcn_fence(__ATOMIC_ACQUIRE, "agent"); asm volatile("s_waitcnt vmcnt(0)" ::: "memory"); }
    __syncthreads();
}

__global__ void __launch_bounds__(512, 2) mk_fwd(Args a) {
    extern __shared__ __attribute__((aligned(16))) unsigned char lds[];
    cg::grid_group grid = cg::this_grid();
    LAS unsigned char* ring = (LAS unsigned char*)lds;
    const int G = gridDim.x, bx = blockIdx.x;
    unsigned char* ws = a.ws;
    const int lo = a.ph_lo, hi = a.ph_hi;
#define IN(k) (lo <= (k) && (k) < hi)
    XcdBarrier xbar; xbar.bar = (unsigned*)ws; xbar.x = xb_xcc_id(); xbar.st = (volatile LAS unsigned*)(ring + (LDS_BYTES - 64));
    if (threadIdx.x == 0) { xbar.st[0] = 0u; xbar.st[1] = 0u; if (hi - lo > 1) (void)xb_add(&xbar.bar[XB_XCNT(xbar.x)], 1u); }
    __syncthreads();
    if (hi > 4096) grid.sync();
#define SEAM(k) do { if (IN(k) && IN((k) + 1)) xcd_barrier(xbar); } while (0)
    const bf16_t* ABUF = (const bf16_t*)(ws + WS_ABUF);

    if (IN(0)) { phase_prologue(a, lds, G); }
    SEAM(0);
    if (IN(1)) {
        { pg8::SchedStd S; S.init(ws + WS_MN, ws + WS_WKV, DM, DM, 1024, 4096, G, bx);
          pg8::EpiKV E{a.out + O_PMK, a.out + O_PMV, (bf16_t*)(ws + WS_KB), (bf16_t*)(ws + WS_VT)};
          pg8::gemm_phase<pg8::EpiKV, pg8::SchedStd, true>(ring, DM, DM, DM, S, E); }
        { const int nwg1 = 4 * 16; pg8::SchedStd S; S.init(ABUF, ws + WS_WIN, DM, DM, MA, ZW, G, (bx + G - (nwg1 % G)) % G); pg8::EpiBf16 E{(bf16_t*)(ws + WS_Z), ZW};
          pg8::gemm_phase<pg8::EpiBf16, pg8::SchedStd, true>(ring, DM, DM, DM, S, E); }
        if (G == 256 && bx >= 212) { __syncthreads(); late_transposes(a, lds, 0, 32 * 88, (bx - 212) * 8 + (threadIdx.x >> 6), 352); }
    }
    SEAM(1);
    if (IN(2)) {
        for (int it = bx; it < 128; it += G) rg_item(a, lds, it >> 5, it & 7, (it >> 3) & 3);
        __syncthreads();
        for (int j = (bx + G - (128 % G)) % G; j < 128; j += G) ml_item(a, lds, j >> 5, (j >> 3) & 3, (j >> 1) & 3, j & 1);
        __syncthreads();
        for (int j = bx; j < NS; j += G) sample_item(a, lds, j);
        __syncthreads();
        if (G == 256) late_transposes(a, lds, 3 * 32 * 88, LATE_ITEMS, bx * 8 + (threadIdx.x >> 6), 2048);
        else late_transposes(a, lds, 0, LATE_ITEMS, bx * 8 + (threadIdx.x >> 6), G * 8);
    }
    SEAM(2);
    if (IN(3)) { phase_finalize(a, lds, G); }
    SEAM(3);
    if (IN(4)) {
        { pg8::SchedStd S; S.init(ws + WS_YMIX, ws + WS_WOUT, DM, DM, NP, DM, G, bx);
          pg8::EpiRes<1> E{a.in[I_XP], a.in[I_XS], (float*)(ws + WS_X1), nullptr, nullptr, a.in[I_GXA], (bf16_t*)(ws + WS_ABUF), (float*)(ws + WS_SSQ1)};
          pg8::gemm_phase<pg8::EpiRes<1>, pg8::SchedStd, true>(ring, DM, DM, DM, S, E); }
        { pg8::SchedSK S{(const char*)(ws + WS_YMIX) + (size_t)NP * DM * 2, (const char*)(ws + WS_WOUT), DM, 8, 8, G, bx}; pg8::EpiPartial E{(float*)(ws + WS_P3), DM};
          pg8::gemm_phase<pg8::EpiPartial, pg8::SchedSK, true>(ring, DM, DM, 256, S, E); }
    }
    SEAM(4);
    if (IN(5)) {
        { const int gw = bx * 8 + (threadIdx.x >> 6); if (gw < NS) sample_prep(a.in[I_XS] + (size_t)gw * DM, (const float*)(ws + WS_P3) + (size_t)gw * DM, 8, a.in[I_GXA], (bf16_t*)(ws + WS_ABUF) + (size_t)(NP + gw) * DM, (float*)(ws + WS_X1S) + (size_t)gw * DM, threadIdx.x & 63); }
        pg8::SchedStd S; S.init(ABUF, ws + WS_WQ, DM, DM, NP, DM, G, bx);
        pg8::EpiQ E{(const float*)(ws + WS_SSQ1), (bf16_t*)(ws + WS_QB), 0.04419417382415922f};
        pg8::gemm_phase<pg8::EpiQ, pg8::SchedStd, true>(ring, DM, DM, DM, S, E);
    }
    SEAM(5);
    if (IN(6)) {
        if (G >= 128) { pg8::SchedS S{(const char*)(ws + WS_QB), (const char*)(ws + WS_KB), G, bx}; pg8::EpiSoftmax E{(bf16_t*)(ws + WS_P)};
            pg8::gemm_phase<pg8::EpiSoftmax, pg8::SchedS, false>(ring, DM, DM, 512, S, E); }
        __syncthreads();
        { pg8::SchedSK S{(const char*)(ws + WS_ABUF) + (size_t)NP * DM * 2, (const char*)(ws + WS_WQ), DM, 8, 8, G, (bx + G - (128 % G)) % G}; pg8::EpiPartial E{(float*)(ws + WS_P4), DM};
          pg8::gemm_phase<pg8::EpiPartial, pg8::SchedSK, true>(ring, DM, DM, 256, S, E); }
        if (G == 256 && bx >= 192) { __syncthreads(); late_transposes(a, lds, 32 * 88, 2 * 32 * 88, (bx - 192) * 8 + (threadIdx.x >> 6), 512); }
    }
    SEAM(6);
    if (IN(7)) {
        { pg8::SchedPV S{(const char*)(ws + WS_P), (const char*)(ws + WS_VT), G, bx}; pg8::EpiBf16 E{(bf16_t*)(ws + WS_OB), DM};
          pg8::gemm_phase<pg8::EpiBf16, pg8::SchedPV, true>(ring, 256, 256, 256, S, E); }
        __syncthreads();
        for (int it = bx; it < NS * 4; it += G) sattn_item(a, lds, it >> 2, it & 3);
    }
    SEAM(7);
    if (IN(8)) {
        { pg8::SchedStd S; S.init(ws + WS_OB, ws + WS_WO, DM, DM, NP, DM, G, bx);
          pg8::EpiRes<2> E{nullptr, nullptr, (float*)(ws + WS_X1), nullptr, nullptr, a.in[I_GFFN], (bf16_t*)(ws + WS_ABUF), (float*)(ws + WS_SSQ2)};
          pg8::gemm_phase<pg8::EpiRes<2>, pg8::SchedStd, true>(ring, DM, DM, DM, S, E); }
        { pg8::SchedSK S{(const char*)(ws + WS_OB) + (size_t)NP * DM * 2, (const char*)(ws + WS_WO), DM, 8, 8, G, bx}; pg8::EpiPartial E{(float*)(ws + WS_P6), DM};
          pg8::gemm_phase<pg8::EpiPartial, pg8::SchedSK, true>(ring, DM, DM, 256, S, E); }
    }
    SEAM(8);
    if (IN(9) && G != 256) {
        const int gw = bx * 8 + (threadIdx.x >> 6); if (gw < NS) sample_prep((const float*)(ws + WS_X1S) + (size_t)gw * DM, (const float*)(ws + WS_P6) + (size_t)gw * DM, 8, a.in[I_GFFN], (bf16_t*)(ws + WS_ABUF) + (size_t)(NP + gw) * DM, (float*)(ws + WS_X2S) + (size_t)gw * DM, threadIdx.x & 63);
    }
    if (G != 256) SEAM(9);
    if (IN(10)) {
        unsigned* flagA = (unsigned*)ws + 8448;
        if (G == 256 && bx >= 172 && bx < 188) {
            const int gw = (bx - 172) * 8 + (threadIdx.x >> 6);
            sample_prep((const float*)(ws + WS_X1S) + (size_t)gw * DM, (const float*)(ws + WS_P6) + (size_t)gw * DM, 8, a.in[I_GFFN], (bf16_t*)(ws + WS_ABUF) + (size_t)(NP + gw) * DM, (float*)(ws + WS_X2S) + (size_t)gw * DM, threadIdx.x & 63);
            flag_signal(flagA); __syncthreads(); }
        { pg8::SchedStd S; S.init(ABUF, ws + WS_WGU, DM, DM, NP, 2 * DFF, G, bx);
          pg8::EpiGU E{(const float*)(ws + WS_SSQ2), (bf16_t*)(ws + WS_H)};
          pg8::gemm_phase<pg8::EpiGU, pg8::SchedStd, true>(ring, DM, DM, DM, S, E); }
        if (G == 256 && bx >= 128 && bx < 172) flag_wait(flagA, 16u);
        { const int nwg1 = (NP / 256) * (2 * DFF / 256); pg8::SchedStd S; S.init(ABUF + (size_t)NP * DM, ws + WS_WGU, DM, DM, 256, 2 * DFF, G, (bx + G - (nwg1 % G)) % G);
          pg8::EpiGU E{nullptr, (bf16_t*)(ws + WS_H) + (size_t)NP * DFF};
          pg8::gemm_phase<pg8::EpiGU, pg8::SchedStd, true>(ring, DM, DM, DM, S, E); }
        if (G == 256 && bx >= 172) { __syncthreads(); late_transposes(a, lds, 2 * 32 * 88, 3 * 32 * 88, (bx - 172) * 8 + (threadIdx.x >> 6), 672); }
    }
    SEAM(10);
    if (IN(11)) {
        if (G == 256) { pg8::SchedStd S; S.init(ws + WS_H, ws + WS_WD, DFF, DFF, NP, DM, G, bx);
          pg8::EpiFinal E{(const float*)(ws + WS_X1), a.out + O_YP, a.in[I_GFIN], (float*)(ws + WS_SLOTS), (unsigned*)ws + 4096};
          pg8::gemm_phase<pg8::EpiFinal, pg8::SchedStd, false>(ring, DFF, DFF, DFF, S, E); }
        else { pg8::SchedStd S; S.init(ws + WS_H, ws + WS_WD, DFF, DFF, NP, DM, G, bx);
          pg8::EpiRes<3> E{nullptr, nullptr, (float*)(ws + WS_X1), a.out + O_YP, a.out + O_YS, nullptr, nullptr, nullptr};
          pg8::gemm_phase<pg8::EpiRes<3>, pg8::SchedStd, true>(ring, DFF, DFF, DFF, S, E); }
        { pg8::SchedSK S{(const char*)(ws + WS_H) + (size_t)NP * DFF * 2, (const char*)(ws + WS_WD), DFF, 8, 22, G, bx}; pg8::EpiPartial E{(float*)(ws + WS_P8), DM};
          pg8::gemm_phase<pg8::EpiPartial, pg8::SchedSK, true>(ring, DFF, DFF, 256, S, E); }
        if (G == 256) { unsigned* flagB = (unsigned*)ws + 8512;
            if (bx < 176) flag_signal(flagB);
            else { __syncthreads(); flag_wait(flagB, 176u); phase_final(a, G, true, bx - 176, 80); } }
    }
    if (G != 256) SEAM(11);
    if (IN(12)) { if (G != 256) phase_final(a, G, false, 0, 1); }
#undef IN
#undef SEAM
}

extern "C" void kernel_launch(void* const* d_in, const int* in_sizes, int n_in, void* d_out, int out_size, void* d_ws, size_t ws_size, hipStream_t stream) {
    static int grid = 0;
    if (grid == 0) {
        if (n_in != 35 || (size_t)out_size != O_END || ws_size < WS_END) { fprintf(stderr, "kernel_launch: unexpected sizes n_in %d out %d ws %zu\n", n_in, out_size, ws_size); grid = -1; return; }
        int dev = 0, cus = 0, per_cu = 0;
        (void)hipGetDevice(&dev); (void)hipDeviceGetAttribute(&cus, hipDeviceAttributeMultiprocessorCount, dev);
        if (hipFuncSetAttribute((const void*)mk_fwd, hipFuncAttributeMaxDynamicSharedMemorySize, LDS_BYTES) != hipSuccess) { fprintf(stderr, "kernel_launch: hipFuncSetAttribute failed\n"); grid = -1; return; }
        if (hipOccupancyMaxActiveBlocksPerMultiprocessor(&per_cu, (const void*)mk_fwd, 512, LDS_BYTES) != hipSuccess || per_cu < 1) { fprintf(stderr, "kernel_launch: occupancy query says %d\n", per_cu); per_cu = 1; }
        (void)hipGetLastError();
        grid = cus * 1;
        if (grid < 128) fprintf(stderr, "kernel_launch: grid %d < 128\n", grid);
    }
    if (grid < 0) return;
    Args a{};
    for (int i = 0; i < 35; ++i) a.in[i] = (const float*)d_in[i];
    a.out = (float*)d_out; a.ws = (unsigned char*)d_ws;
    constexpr int NL = MK_N_LAUNCHES;
    if (hipMemsetAsync(d_ws, 0, 36864, stream) != hipSuccess) { fprintf(stderr, "kernel_launch: memset of the barrier word failed\n"); return; }
    for (int li = 0; li < NL; ++li) {
        a.ph_lo = (NL == 1) ? 0 : li; a.ph_hi = (NL == 1) ? N_PHASES : li + 1;
        void* args[] = {&a};
        hipError_t e = hipLaunchCooperativeKernel((const void*)mk_fwd, dim3(grid), dim3(512), args, LDS_BYTES, stream);
        if (e != hipSuccess) { fprintf(stderr, "kernel_launch: cooperative launch %d failed: %s (grid %d)\n", li, hipGetErrorString(e), grid); break; }
    }
}
```

```cpp
#include <hip/hip_runtime.h>
#include <hip/hip_cooperative_groups.h>
#include <cstdio>
#include <cstdint>
namespace cg = cooperative_groups;

#ifndef MK_N_LAUNCHES
#define MK_N_LAUNCHES 1
#endif

#define LAS __attribute__((address_space(3)))
typedef unsigned short bf16_t;
typedef short bf16x8 __attribute__((ext_vector_type(8)));
typedef float f32x4 __attribute__((ext_vector_type(4)));
typedef unsigned u32x4 __attribute__((ext_vector_type(4)));
typedef unsigned u32x2 __attribute__((ext_vector_type(2)));

constexpr int DM = 2048, NP = 8192, NS = 128, MV = NP + NS, MA = 8448, ZW = 5120, INW = 5128, DFF = 5632, SEQ = 2048, NMEM = 256;
constexpr float EPS = 1e-6f;
constexpr int N_PHASES = 13;

constexpr size_t O_YP = 0, O_YS = O_YP + (size_t)NP * DM, O_PRGH = O_YS + (size_t)NS * DM, O_PRGC = O_PRGH + 4096, O_PMLC = O_PRGC + 12288,
                 O_PMLN = O_PMLC + 524288, O_PMLM = O_PMLN + 2048, O_PMK = O_PMLM + 16, O_PMV = O_PMK + 2097152, O_SRGH = O_PMV + 2097152,
                 O_SRGC = O_SRGH + 131072, O_SMLC = O_SRGC + 393216, O_SMLN = O_SMLC + 16777216, O_SMLM = O_SMLN + 65536, O_END = O_SMLM + 512;

constexpr size_t MiB = 1u << 20;
constexpr size_t WS_WIN = 1 * MiB, WS_WOUT = 21 * MiB, WS_WQ = 29 * MiB, WS_WKV = 37 * MiB, WS_WO = 53 * MiB, WS_WGU = 61 * MiB, WS_WD = 105 * MiB,
                 WS_WRG = 127 * MiB, WS_ABUF = 128 * MiB, WS_MN = 161 * MiB, WS_Z = 165 * MiB, WS_GATES = 248 * MiB, WS_YPRE = 249 * MiB,
                 WS_HPRE = 282 * MiB, WS_YMIX = 315 * MiB, WS_X1 = 348 * MiB, WS_SSQ1 = 414 * MiB, WS_SSQ2 = 416 * MiB, WS_QB = 418 * MiB,
                 WS_OB = 451 * MiB, WS_KB = 484 * MiB, WS_VT = 488 * MiB, WS_P = 492 * MiB, WS_H = 508 * MiB, WS_X1S = 600 * MiB, WS_X2S = 601 * MiB, WS_P3 = 604 * MiB, WS_P4 = 612 * MiB, WS_P6 = 620 * MiB, WS_P8 = 628 * MiB, WS_CPRE = 652 * MiB, WS_RGE = 685 * MiB, WS_MLS = 686 * MiB, WS_CIN = 687 * MiB, WS_CINF = 689 * MiB, WS_GL = 692 * MiB, WS_SLOTS = 693 * MiB, WS_END = 694 * MiB;

constexpr int LDS_BYTES = 147456;

__device__ __forceinline__ unsigned cvt_pk_bf16(float lo, float hi) { unsigned r; asm volatile("v_cvt_pk_bf16_f32 %0, %1, %2" : "=v"(r) : "v"(lo), "v"(hi)); return r; }
__device__ __forceinline__ float bf2f(unsigned short b) { return __uint_as_float((unsigned)b << 16); }
__device__ __forceinline__ bf16_t f2bf(float f) { return (bf16_t)(cvt_pk_bf16(f, 0.f) & 0xffffu); }
__device__ __forceinline__ float bflo(unsigned w) { return __uint_as_float(w << 16); }
__device__ __forceinline__ float bfhi(unsigned w) { return __uint_as_float(w & 0xffff0000u); }
__device__ __forceinline__ float wave_sum(float v) {
#pragma unroll
    for (int o = 1; o < 64; o <<= 1) v += __shfl_xor(v, o);
    return v;
}
__device__ __forceinline__ float wave_max(float v) {
#pragma unroll
    for (int o = 1; o < 64; o <<= 1) v = fmaxf(v, __shfl_xor(v, o));
    return v;
}
__device__ __forceinline__ float sigmoidf_(float x) { return __builtin_amdgcn_rcpf(1.f + __expf(-x)); }
__device__ __forceinline__ float gelu_tanh(float x) { const float u = 0.7978845608028654f * (x + 0.044715f * x * x * x); return 0.5f * x * (1.f + tanhf(u)); }
#define LDS_WAIT() asm volatile("s_waitcnt lgkmcnt(0)" ::: "memory")
#define LBAR() do { asm volatile("s_waitcnt lgkmcnt(0)" ::: "memory"); __builtin_amdgcn_s_barrier(); asm volatile("" ::: "memory"); } while (0)

namespace pg8 {
constexpr int BM = 256, BK = 64, HALF = 128, HTB = HALF * BK * 2, STAGE_BYTES = 8 * HTB, NXCD = 8, WGM = 8;
__host__ __device__ __forceinline__ int lds_byte(int r, int c) { const int st = (r >> 4) * 2 + (c >> 5), rr = r & 15, cc = c & 31, ob = rr * 64 + cc * 2; return st * 1024 + (ob ^ (((ob >> 9) & 1) << 5)); }
__host__ __device__ __forceinline__ void stage_rc(int b, int& R, int& C) { const int st = b / 1024, sb = b % 1024, swz = sb ^ (((sb >> 9) & 1) << 5); R = (st >> 1) * 16 + swz / 64; C = (st & 1) * 32 + (swz % 64) / 2; }
__host__ __device__ __forceinline__ int perm32(int rho) { const int n = rho >> 4, i = rho & 15; return 8 * (i >> 2) + 4 * n + (i & 3); }

struct Unit { int pm, pn; };

struct SchedStd {
    const char* A; const char* B; size_t sA, sB; int nM, nN, nwg, G, c;
    __device__ void init(const void* A_, const void* B_, int lda, int ldb, int M, int N, int G_, int c_) {
        A = (const char*)A_; B = (const char*)B_; sA = (size_t)BM * lda * 2; sB = (size_t)BM * ldb * 2; nM = M / BM; nN = N / BM; nwg = nM * nN; G = G_; c = c_; }
    __device__ bool next(int i, Unit& u) const {
        const long L = (long)i * G + c; if (L >= nwg) return false;
        int wgid = (int)L; { const int q = nwg / NXCD, r = nwg % NXCD, xcd = wgid % NXCD, off = wgid / NXCD; wgid = (xcd < r ? xcd * (q + 1) : r * (q + 1) + (xcd - r) * q) + off; }
        const int nig = WGM * nN, gid = wgid / nig, fm = gid * WGM, gsz = (nM - fm) < WGM ? (nM - fm) : WGM;
        u.pm = fm + ((wgid % nig) % gsz); u.pn = (wgid % nig) / gsz; return true;
    }
    __device__ __forceinline__ const char* aptr(const Unit& u) const { return A + (size_t)u.pm * sA; }
    __device__ __forceinline__ const char* bptr(const Unit& u) const { return B + (size_t)u.pn * sB; }
};
struct SchedS {
    const char* Q; const char* Kb; int G, c;
    __device__ bool next(int i, Unit& u) const { const int L = i * G + c; if (L >= 128) return false; const int b = L >> 5, h = (L >> 3) & 3, qt = L & 7; u.pm = b * 8 + qt; u.pn = h; return true; }
    __device__ __forceinline__ const char* aptr(const Unit& u) const { return Q + ((size_t)u.pm * 256 * DM + (size_t)u.pn * 512) * 2; }
    __device__ __forceinline__ const char* bptr(const Unit& u) const { return Kb + ((size_t)(u.pm >> 3) * 256 * DM + (size_t)u.pn * 512) * 2; }
};
struct SchedPV {
    const char* P; const char* VT; int G, c;
    __device__ bool next(int i, Unit& u) const { const int L = i * G + c; if (L >= 256) return false; const int bh = L >> 4, qt = (L >> 1) & 7, nh = L & 1; u.pm = (bh >> 2) * 8 + qt; u.pn = (bh & 3) * 2 + nh; return true; }
    __device__ __forceinline__ const char* aptr(const Unit& u) const { const int bh = (u.pm >> 3) * 4 + (u.pn >> 1); return P + ((size_t)bh * 2048 + (size_t)(u.pm & 7) * 256) * 256 * 2; }
    __device__ __forceinline__ const char* bptr(const Unit& u) const { const int bh = (u.pm >> 3) * 4 + (u.pn >> 1); return VT + ((size_t)bh * 512 + (size_t)(u.pn & 1) * 256) * 256 * 2; }
};

typedef f32x4 Acc[2][2][4][2];
__device__ __forceinline__ u32x4 pack8(const f32x4 v0, const f32x4 v1) { u32x4 w; w.x = cvt_pk_bf16(v0[0], v0[1]); w.y = cvt_pk_bf16(v0[2], v0[3]); w.z = cvt_pk_bf16(v1[0], v1[1]); w.w = cvt_pk_bf16(v1[2], v1[3]); return w; }

struct EpiBf16 {
    static constexpr bool PERM = true, AFTER_DRAIN = false;
    bf16_t* O; int ldc;
    __device__ __forceinline__ void operator()(const Acc& acc, const Unit& u, int wr, int wc, int fr, int fq) const {
        const int row0 = u.pm * BM + wr * 64 + fr, col0 = u.pn * BM + wc * 32 + 8 * fq;
#pragma unroll
        for (int ai = 0; ai < 2; ++ai)
#pragma unroll
            for (int m = 0; m < 4; ++m) { bf16_t* rowp = O + (size_t)(row0 + ai * HALF + m * 16) * ldc + col0;
#pragma unroll
                for (int bj = 0; bj < 2; ++bj) *(u32x4*)(rowp + bj * HALF) = pack8(acc[ai][bj][m][0], acc[ai][bj][m][1]); }
    }
};
struct EpiKV {
    static constexpr bool PERM = true, AFTER_DRAIN = false;
    float* outK; float* outV; bf16_t* KB; bf16_t* VT;
    __device__ __forceinline__ void operator()(const Acc& acc, const Unit& u, int wr, int wc, int fr, int fq) const {
        const int row0 = u.pm * BM + wr * 64 + fr, col0 = (u.pn & 7) * BM + wc * 32 + 8 * fq; const bool isV = u.pn >= 8;
#pragma unroll
        for (int ai = 0; ai < 2; ++ai)
#pragma unroll
            for (int m = 0; m < 4; ++m) { const int r = row0 + ai * HALF + m * 16;
#pragma unroll
                for (int bj = 0; bj < 2; ++bj) { const int c = col0 + bj * HALF; const f32x4 v0 = acc[ai][bj][m][0], v1 = acc[ai][bj][m][1];
                    float* o = (isV ? outV : outK) + (size_t)r * DM + c; *(f32x4*)o = v0; *(f32x4*)(o + 4) = v1;
                    if (!isV) *(u32x4*)(KB + (size_t)r * DM + c) = pack8(v0, v1);
                    else { const int b = r >> 8, mm = r & 255, h = c >> 9, d = c & 511; bf16_t* base = VT + ((size_t)((b * 4 + h) * 512 + d)) * 256 + mm;
#pragma unroll
                        for (int e = 0; e < 4; ++e) { base[(size_t)e * 256] = f2bf(v0[e]); base[(size_t)(4 + e) * 256] = f2bf(v1[e]); } } } }
    }
};
template <int MODE> struct EpiRes {
    static constexpr bool PERM = true, AFTER_DRAIN = false;
    const float* xp; const float* xs; float* X1; float* yp; float* ys; const float* g; bf16_t* Aout; float* SSQ;
    __device__ __forceinline__ void operator()(const Acc& acc, const Unit& u, int wr, int wc, int fr, int fq) const {
        const int row0 = u.pm * BM + wr * 64 + fr, col0 = u.pn * BM + wc * 32 + 8 * fq;
        f32x4 gv[2][2];
        if (MODE != 3) {
#pragma unroll
            for (int bj = 0; bj < 2; ++bj)
#pragma unroll
                for (int n = 0; n < 2; ++n) gv[bj][n] = *(const f32x4*)(g + col0 + bj * HALF + 4 * n); }
#pragma unroll
        for (int ai = 0; ai < 2; ++ai)
#pragma unroll
            for (int m = 0; m < 4; ++m) { const int r = row0 + ai * HALF + m * 16;
                const float* src; float* dst;
                if (MODE == 1) { const int rc = r < MV ? r : MV - 1; src = rc < NP ? xp + (size_t)rc * DM : xs + (size_t)(rc - NP) * DM; dst = X1 + (size_t)r * DM; }
                else if (MODE == 2) { src = X1 + (size_t)r * DM; dst = X1 + (size_t)r * DM; }
                else { src = X1 + (size_t)r * DM; dst = r < NP ? yp + (size_t)r * DM : (r < MV ? ys + (size_t)(r - NP) * DM : X1 + (size_t)r * DM); }
                float ss = 0.f;
#pragma unroll
                for (int bj = 0; bj < 2; ++bj) { const int c = col0 + bj * HALF;
                    const f32x4 v0 = *(const f32x4*)(src + c) + acc[ai][bj][m][0], v1 = *(const f32x4*)(src + c + 4) + acc[ai][bj][m][1];
                    *(f32x4*)(dst + c) = v0; *(f32x4*)(dst + c + 4) = v1;
                    if (MODE != 3) { ss += (v0[0] * v0[0] + v0[1] * v0[1]) + (v0[2] * v0[2] + v0[3] * v0[3]) + (v1[0] * v1[0] + v1[1] * v1[1]) + (v1[2] * v1[2] + v1[3] * v1[3]);
                        *(u32x4*)(Aout + (size_t)r * DM + c) = pack8(v0 * gv[bj][0], v1 * gv[bj][1]); } }
                if (MODE != 3) { ss += __shfl_xor(ss, 16); ss += __shfl_xor(ss, 32); if (fq == 0) SSQ[(size_t)r * 32 + u.pn * 4 + wc] = ss; }
                if (m & 1) asm volatile("" ::: "memory"); }
    }
};
__device__ __forceinline__ float row_rstd(const float* SSQ, int r, int fq) {
    const float* p = SSQ + (size_t)r * 32 + fq * 8; const f32x4 t0 = *(const f32x4*)p, t1 = *(const f32x4*)(p + 4);
    float s = (t0[0] + t0[1]) + (t0[2] + t0[3]) + (t1[0] + t1[1]) + (t1[2] + t1[3]); s += __shfl_xor(s, 16); s += __shfl_xor(s, 32);
    return rsqrtf(s * (1.f / DM) + EPS);
}
struct EpiQ {
    static constexpr bool PERM = true, AFTER_DRAIN = false;
    const float* SSQ; bf16_t* O; float scale;
    __device__ __forceinline__ void operator()(const Acc& acc, const Unit& u, int wr, int wc, int fr, int fq) const {
        const int row0 = u.pm * BM + wr * 64 + fr, col0 = u.pn * BM + wc * 32 + 8 * fq;
#pragma unroll
        for (int ai = 0; ai < 2; ++ai)
#pragma unroll
            for (int m = 0; m < 4; ++m) { const int r = row0 + ai * HALF + m * 16; const float rs = row_rstd(SSQ, r, fq) * scale; bf16_t* rowp = O + (size_t)r * DM + col0;
#pragma unroll
                for (int bj = 0; bj < 2; ++bj) *(u32x4*)(rowp + bj * HALF) = pack8(acc[ai][bj][m][0] * rs, acc[ai][bj][m][1] * rs); }
    }
};
struct EpiGU {
    static constexpr bool PERM = true, AFTER_DRAIN = false;
    const float* SSQ; bf16_t* H;
    __device__ __forceinline__ void operator()(const Acc& acc, const Unit& u, int wr, int wc, int fr, int fq) const {
        const int row0 = u.pm * BM + wr * 64 + fr, col0 = u.pn * HALF + wc * 32 + 8 * fq;
#pragma unroll
        for (int ai = 0; ai < 2; ++ai)
#pragma unroll
            for (int m = 0; m < 4; ++m) { const int r = row0 + ai * HALF + m * 16; const float rs = SSQ ? row_rstd(SSQ, r, fq) : 1.f; f32x4 hv[2];
#pragma unroll
                for (int n = 0; n < 2; ++n)
#pragma unroll
                    for (int j = 0; j < 4; ++j) { const float gg = acc[ai][0][m][n][j] * rs, uu = acc[ai][1][m][n][j] * rs; hv[n][j] = gg * sigmoidf_(gg) * uu; }
                *(u32x4*)(H + (size_t)r * DFF + col0) = pack8(hv[0], hv[1]); }
    }
};
struct EpiSoftmax {
    static constexpr bool PERM = true, AFTER_DRAIN = true;
    bf16_t* P;
    __device__ __forceinline__ void operator()(const Acc&, const Unit&, int, int, int, int) const {}
    __device__ __forceinline__ void fused(Acc& acc, const Unit& u, int wr, int wc, int fr, int fq, LAS unsigned char* lds, int wid, int lane) const {
        LAS float* PM = (LAS float*)lds; LAS float* PS = (LAS float*)(lds + 4096);
#pragma unroll
        for (int ai = 0; ai < 2; ++ai)
#pragma unroll
            for (int m = 0; m < 4; ++m) { float mx = -3.0e38f;
#pragma unroll
                for (int bj = 0; bj < 2; ++bj)
#pragma unroll
                    for (int n = 0; n < 2; ++n) { const f32x4 x = acc[ai][bj][m][n]; mx = fmaxf(mx, fmaxf(fmaxf(x[0], x[1]), fmaxf(x[2], x[3]))); }
                mx = fmaxf(mx, __shfl_xor(mx, 16)); mx = fmaxf(mx, __shfl_xor(mx, 32));
                if (fq == 0) PM[(ai * HALF + wr * 64 + m * 16 + fr) * 4 + wc] = mx; }
        LDS_WAIT(); __builtin_amdgcn_s_barrier(); asm volatile("" ::: "memory");
#pragma unroll
        for (int ai = 0; ai < 2; ++ai)
#pragma unroll
            for (int m = 0; m < 4; ++m) { const int rl = ai * HALF + wr * 64 + m * 16 + fr; const f32x4 pm = *(const LAS f32x4*)(PM + rl * 4);
                const float M = fmaxf(fmaxf(pm[0], pm[1]), fmaxf(pm[2], pm[3])); float s = 0.f;
#pragma unroll
                for (int bj = 0; bj < 2; ++bj)
#pragma unroll
                    for (int n = 0; n < 2; ++n)
#pragma unroll
                        for (int j = 0; j < 4; ++j) { const float e = __expf(acc[ai][bj][m][n][j] - M); acc[ai][bj][m][n][j] = e; s += e; }
                s += __shfl_xor(s, 16); s += __shfl_xor(s, 32);
                if (fq == 0) PS[rl * 4 + wc] = s; }
        LDS_WAIT(); __builtin_amdgcn_s_barrier(); asm volatile("" ::: "memory");
        const int b = u.pm >> 3, qt = u.pm & 7, h = u.pn;
#pragma unroll
        for (int ai = 0; ai < 2; ++ai)
#pragma unroll
            for (int m = 0; m < 4; ++m) { const int rl = ai * HALF + wr * 64 + m * 16 + fr; const f32x4 ps = *(const LAS f32x4*)(PS + rl * 4);
                const float inv = 1.f / ((ps[0] + ps[1]) + (ps[2] + ps[3]));
                bf16_t* rowp = P + ((size_t)((b * 4 + h) * 2048 + qt * 256 + rl)) * 256 + wc * 32 + 8 * fq;
#pragma unroll
                for (int bj = 0; bj < 2; ++bj) *(u32x4*)(rowp + bj * HALF) = pack8(acc[ai][bj][m][0] * inv, acc[ai][bj][m][1] * inv); }
        LDS_WAIT(); __builtin_amdgcn_s_barrier(); asm volatile("" ::: "memory");
    }
};

struct SchedSK {
    const char* A; const char* B; int ldb, npn, nks, G, c;
    __device__ bool next(int i, Unit& u) const { const int L = i * G + c; if (L >= npn * nks) return false; u.pn = L % npn; u.pm = L / npn; return true; }
    __device__ __forceinline__ const char* aptr(const Unit& u) const { return A + (size_t)u.pm * 512; }
    __device__ __forceinline__ const char* bptr(const Unit& u) const { return B + ((size_t)u.pn * 256 * ldb + (size_t)u.pm * 256) * 2; }
};
struct EpiPartial {
    static constexpr bool PERM = true, AFTER_DRAIN = false;
    float* D; int ld;
    __device__ __forceinline__ void operator()(const Acc& acc, const Unit& u, int wr, int wc, int fr, int fq) const {
        const int col0 = u.pn * BM + wc * 32 + 8 * fq;
#pragma unroll
        for (int m = 0; m < 4; ++m) { float* rowp = D + ((size_t)u.pm * 128 + wr * 64 + m * 16 + fr) * ld + col0;
#pragma unroll
            for (int bj = 0; bj < 2; ++bj) { *(f32x4*)(rowp + bj * HALF) = acc[0][bj][m][0]; *(f32x4*)(rowp + bj * HALF + 4) = acc[0][bj][m][1]; } }
    }
};

struct EpiFinal {
    static constexpr bool PERM = true, AFTER_DRAIN = true;
    const float* X1; float* yp; const float* g; float* slots; unsigned* cnt;
    __device__ __forceinline__ void operator()(const Acc&, const Unit&, int, int, int, int) const {}
    __device__ __forceinline__ void fused(Acc& acc, const Unit& u, int wr, int wc, int fr, int fq, LAS unsigned char* lds, int wid, int lane) const {
        LAS float* P = (LAS float*)lds;
        LAS float* S = (LAS float*)(lds + 4096);
        const int col0 = u.pn * BM + wc * 32 + 8 * fq;
#pragma unroll
        for (int ai = 0; ai < 2; ++ai)
#pragma unroll
            for (int m = 0; m < 4; ++m) { const int rl = ai * HALF + wr * 64 + m * 16 + fr; const float* src = X1 + (size_t)(u.pm * BM + rl) * DM + col0; float ss = 0.f;
#pragma unroll
                for (int bj = 0; bj < 2; ++bj) { acc[ai][bj][m][0] += *(const f32x4*)(src + bj * HALF); acc[ai][bj][m][1] += *(const f32x4*)(src + bj * HALF + 4);
                    const f32x4 v0 = acc[ai][bj][m][0], v1 = acc[ai][bj][m][1];
                    ss += (v0[0] * v0[0] + v0[1] * v0[1]) + (v0[2] * v0[2] + v0[3] * v0[3]) + (v1[0] * v1[0] + v1[1] * v1[1]) + (v1[2] * v1[2] + v1[3] * v1[3]); }
                ss += __shfl_xor(ss, 16); ss += __shfl_xor(ss, 32);
                if (fq == 0) P[rl * 4 + wc] = ss;
                if (m & 1) asm volatile("" ::: "memory"); }
        LDS_WAIT(); __builtin_amdgcn_s_barrier(); asm volatile("" ::: "memory");
        const int row = wid * 32 + (lane & 31);
        if (lane < 32) { const f32x4 p = *(const LAS f32x4*)(P + row * 4);
            __hip_atomic_store(slots + ((size_t)(u.pm * BM + row)) * 8 + u.pn, (p[0] + p[1]) + (p[2] + p[3]), __ATOMIC_RELAXED, __HIP_MEMORY_SCOPE_AGENT); }
        asm volatile("s_waitcnt vmcnt(0)" ::: "memory");
        if (lane == 0) __hip_atomic_fetch_add(cnt + 64 * u.pm, 1u, __ATOMIC_RELAXED, __HIP_MEMORY_SCOPE_AGENT);
        if (wid == 0) {
            unsigned sp = 0u;
            while ((unsigned)__builtin_amdgcn_readfirstlane(__hip_atomic_load(cnt + 64 * u.pm, __ATOMIC_RELAXED, __HIP_MEMORY_SCOPE_AGENT)) < 64u) { __builtin_amdgcn_s_sleep(2); if (++sp > (1u << 20)) break; }
            __builtin_amdgcn_fence(__ATOMIC_ACQUIRE, "agent");
        }
        asm volatile("s_waitcnt vmcnt(0) lgkmcnt(0)" ::: "memory"); __builtin_amdgcn_s_barrier(); asm volatile("" ::: "memory");
        if (lane < 32) { const float* sl = slots + ((size_t)(u.pm * BM + row)) * 8; float tot = 0.f;
#pragma unroll
            for (int t = 0; t < 8; ++t) tot += __hip_atomic_load(sl + t, __ATOMIC_RELAXED, __HIP_MEMORY_SCOPE_AGENT);
            S[row] = rsqrtf(tot * (1.f / DM) + EPS); }
        LDS_WAIT(); __builtin_amdgcn_s_barrier(); asm volatile("" ::: "memory");
        f32x4 gv[2][2];
#pragma unroll
        for (int bj = 0; bj < 2; ++bj)
#pragma unroll
            for (int n = 0; n < 2; ++n) gv[bj][n] = *(const f32x4*)(g + col0 + bj * HALF + 4 * n);
#pragma unroll
        for (int ai = 0; ai < 2; ++ai)
#pragma unroll
            for (int m = 0; m < 4; ++m) { const int rl = ai * HALF + wr * 64 + m * 16 + fr; const float rs = S[rl]; float* dst = yp + (size_t)(u.pm * BM + rl) * DM + col0;
#pragma unroll
                for (int bj = 0; bj < 2; ++bj) { *(f32x4*)(dst + bj * HALF) = acc[ai][bj][m][0] * rs * gv[bj][0]; *(f32x4*)(dst + bj * HALF + 4) = acc[ai][bj][m][1] * rs * gv[bj][1]; } }
        LDS_WAIT(); __builtin_amdgcn_s_barrier(); asm volatile("" ::: "memory");
    }
};

template <class Epi, class Sched, bool ALIGN_EPI>
__device__ __forceinline__ void gemm_phase(LAS unsigned char* lds, const int lda, const int ldb, const int K, const Sched& S, const Epi& E) {
    const int tid = threadIdx.x, wid = __builtin_amdgcn_readfirstlane(tid >> 6), lane = tid & 63, wr = wid >> 2, wc = wid & 3, fr = lane & 15, fq = lane >> 4;
    const int nt = K / BK;
    unsigned voffA[2], voffB[2];
#pragma unroll
    for (int i = 0; i < 2; ++i) { int R, C; stage_rc(tid * 16 + i * 8192, R, C); const int Rb = Epi::PERM ? ((R & ~31) + perm32(R & 31)) : R;
        voffA[i] = (unsigned)(R * lda + C) * 2u; voffB[i] = (unsigned)(Rb * ldb + C) * 2u; }
    const size_t kstep = (size_t)(BK * 2);
    const size_t hA = (size_t)HALF * lda * 2, hB = (size_t)HALF * ldb * 2;
    const unsigned ldsw = (unsigned)wid * 1024u;
    const int aoff = lds_byte(wr * 64 + fr, fq * 8), boff = lds_byte(wc * 32 + fr, fq * 8);
#define PG8_SA(b, h) (((b) * 2 + (h)) * HTB)
#define PG8_SB(b, h) ((4 + (b) * 2 + (h)) * HTB)
#define PG8_STAGE(bufoff, gbase, voff) do { _Pragma("unroll") for (int _i = 0; _i < 2; ++_i) \
        __builtin_amdgcn_global_load_lds((const unsigned*)((const char*)(gbase) + (voff)[_i]), (LAS unsigned*)(lds + (bufoff) + ldsw + _i * 8192), 16, 0, 0); } while (0)
#define PG8_LDA(dst, b, h) do { _Pragma("unroll") for (int m = 0; m < 4; ++m) _Pragma("unroll") for (int k = 0; k < 2; ++k) dst[m][k] = *(const LAS bf16x8*)(lds + PG8_SA(b, h) + aoff + m * 2048 + k * 1024); } while (0)
#define PG8_LDB(dst, b, h) do { _Pragma("unroll") for (int n = 0; n < 2; ++n) _Pragma("unroll") for (int k = 0; k < 2; ++k) dst[n][k] = *(const LAS bf16x8*)(lds + PG8_SB(b, h) + boff + n * 2048 + k * 1024); } while (0)
#define PG8_MMA(ai, bj, At, Bt) do { __builtin_amdgcn_s_setprio(1); _Pragma("unroll") for (int m = 0; m < 4; ++m) _Pragma("unroll") for (int n = 0; n < 2; ++n) _Pragma("unroll") for (int k = 0; k < 2; ++k) \
        acc[ai][bj][m][n] = __builtin_amdgcn_mfma_f32_16x16x32_bf16(Bt[n][k], At[m][k], acc[ai][bj][m][n], 0, 0, 0); __builtin_amdgcn_s_setprio(0); } while (0)
#define PG8_WAIT_V(n) asm volatile("s_waitcnt vmcnt(" #n ")" ::: "memory")
#define PG8_WAIT_L(n) asm volatile("s_waitcnt lgkmcnt(" #n ")" ::: "memory")
#define PG8_BAR __builtin_amdgcn_s_barrier()
#define PG8_SCHED __builtin_amdgcn_sched_barrier(0)
    Unit cur, nxt; int ui = 0;
    if (!S.next(0, cur)) return;
    Acc acc;
#pragma unroll
    for (int a = 0; a < 2; ++a)
#pragma unroll
        for (int b = 0; b < 2; ++b)
#pragma unroll
            for (int m = 0; m < 4; ++m)
#pragma unroll
                for (int n = 0; n < 2; ++n) acc[a][b][m][n] = (f32x4){0.f, 0.f, 0.f, 0.f};
    bf16x8 At[4][2], B0[2][2], B1[2][2];
    const char* cA = S.aptr(cur); const char* cB = S.bptr(cur);
    PG8_STAGE(PG8_SB(0, 0), cB, voffB); PG8_STAGE(PG8_SB(0, 1), cB + hB, voffB); PG8_STAGE(PG8_SA(0, 0), cA, voffA); PG8_STAGE(PG8_SA(0, 1), cA + hA, voffA);
    if (wr == 1) PG8_BAR;
    PG8_WAIT_V(2); PG8_BAR;
    PG8_STAGE(PG8_SB(1, 0), cB + kstep, voffB); PG8_STAGE(PG8_SA(1, 0), cA + kstep, voffA); PG8_STAGE(PG8_SB(1, 1), cB + hB + kstep, voffB);
    PG8_WAIT_V(6); PG8_BAR;
    for (;;) {
        const bool has_next = S.next(ui + 1, nxt);
        const char* nA = has_next ? S.aptr(nxt) : cA; const char* nB = has_next ? S.bptr(nxt) : cB;
#pragma unroll 1
        for (int t = 0; t < nt; t += 2) {
            const bool last = (t == nt - 2);
            const char* a1 = cA + (size_t)(t + 1) * kstep;
            const char* a2 = last ? nA : cA + (size_t)(t + 2) * kstep; const char* b2 = last ? nB : cB + (size_t)(t + 2) * kstep;
            const char* a3 = a2 + kstep; const char* b3 = b2 + kstep;
            PG8_LDB(B0, 0, 0); PG8_LDB(B1, 0, 1); PG8_SCHED; PG8_LDA(At, 0, 0); PG8_STAGE(PG8_SA(1, 1), a1 + hA, voffA);
            PG8_WAIT_V(8); PG8_WAIT_L(0); PG8_BAR; PG8_MMA(0, 0, At, B0); PG8_MMA(0, 1, At, B1); PG8_BAR; PG8_SCHED;
            PG8_LDA(At, 0, 1); PG8_STAGE(PG8_SB(0, 0), b2, voffB); PG8_STAGE(PG8_SB(0, 1), b2 + hB, voffB); PG8_STAGE(PG8_SA(0, 0), a2, voffA);
            PG8_WAIT_V(8); PG8_WAIT_L(0); PG8_BAR; PG8_MMA(1, 0, At, B0); PG8_MMA(1, 1, At, B1); PG8_BAR; PG8_SCHED;
            PG8_LDB(B0, 1, 0); PG8_LDB(B1, 1, 1); PG8_SCHED; PG8_LDA(At, 1, 0); PG8_STAGE(PG8_SA(0, 1), a2 + hA, voffA);
            PG8_WAIT_V(8); PG8_WAIT_L(0); PG8_BAR; PG8_MMA(0, 0, At, B0); PG8_MMA(0, 1, At, B1); PG8_BAR; PG8_SCHED;
            PG8_LDA(At, 1, 1); PG8_STAGE(PG8_SB(1, 0), b3, voffB); PG8_STAGE(PG8_SB(1, 1), b3 + hB, voffB); PG8_STAGE(PG8_SA(1, 0), a3, voffA);
            PG8_WAIT_V(8); PG8_WAIT_L(0); PG8_BAR; PG8_MMA(1, 0, At, B0); PG8_MMA(1, 1, At, B1); PG8_BAR; PG8_SCHED;
        }
        if constexpr (ALIGN_EPI) { if (wr == 0) PG8_BAR; }
        if constexpr (!Epi::AFTER_DRAIN) { E(acc, cur, wr, wc, fr, fq); }
        if (!has_next) break;
#pragma unroll
        for (int a = 0; a < 2; ++a)
#pragma unroll
            for (int b = 0; b < 2; ++b)
#pragma unroll
                for (int m = 0; m < 4; ++m)
#pragma unroll
                    for (int n = 0; n < 2; ++n) acc[a][b][m][n] = (f32x4){0.f, 0.f, 0.f, 0.f};
        cur = nxt; cA = nA; cB = nB; ++ui;
        if constexpr (ALIGN_EPI) { if (wr == 1) PG8_BAR; }
    }
    PG8_WAIT_V(0);
    if constexpr (!ALIGN_EPI) { if (wr == 0) PG8_BAR; }
    PG8_BAR;
    if constexpr (Epi::AFTER_DRAIN) { E.fused(acc, cur, wr, wc, fr, fq, lds, wid, lane); }
#undef PG8_SA
#undef PG8_SB
#undef PG8_STAGE
#undef PG8_LDA
#undef PG8_LDB
#undef PG8_MMA
#undef PG8_WAIT_V
#undef PG8_WAIT_L
#undef PG8_BAR
#undef PG8_SCHED
}
}

struct Args { const float* in[35]; float* out; unsigned char* ws; int ph_lo, ph_hi; };
enum { I_XP = 0, I_XS, I_MEM, I_SRGH, I_SRGC, I_SMLC, I_SMLN, I_SMLM, I_CK, I_CV, I_GMIX, I_WIN, I_CONVW, I_CONVB, I_WRGA, I_BRGA, I_WRGX, I_BRGX, I_LAM,
       I_BMLI, I_BMLF, I_GRG, I_GML, I_WOUT, I_GXA, I_GMEM, I_WQ, I_WK, I_WV, I_WO, I_GFFN, I_WG, I_WU, I_WD, I_GFIN };

__device__ __forceinline__ void tr_item(const float* W, int ldw, bf16_t* dst, int ldd, LAS float* scr, int lane) {
#pragma unroll
    for (int hf = 0; hf < 2; ++hf) { float v[32];
#pragma unroll
        for (int kk = 0; kk < 32; ++kk) v[kk] = W[(size_t)(hf * 32 + kk) * ldw + lane];
#pragma unroll
        for (int kk = 0; kk < 32; ++kk) scr[(hf * 32 + kk) * 65 + lane] = v[kk]; }
    LDS_WAIT();
    const int c = lane & 7;
#pragma unroll
    for (int j = 0; j < 8; ++j) { const int n = (lane >> 3) + 8 * j; const LAS float* s = scr + (8 * c) * 65 + n;
        u32x4 o; o.x = cvt_pk_bf16(s[0], s[65]); o.y = cvt_pk_bf16(s[2 * 65], s[3 * 65]); o.z = cvt_pk_bf16(s[4 * 65], s[5 * 65]); o.w = cvt_pk_bf16(s[6 * 65], s[7 * 65]);
        *(u32x4*)(dst + (size_t)n * ldd + 8 * c) = o; }
    LDS_WAIT();
}
template <int MAP> __device__ __forceinline__ void tr_mat(int it, const float* W, int ldw, int ncols, bf16_t* dst, int ldd, LAS float* scr, int lane) {
    const int nblk = ncols / 64, kb = it / nblk, nb = it % nblk, k0 = kb * 64, n0 = nb * 64;
    const int drow = MAP == 0 ? n0 : ((n0 >> 7) * 256 + (n0 & 127) + (MAP == 2 ? 128 : 0));
    tr_item(W + (size_t)k0 * ldw + n0, ldw, dst + (size_t)drow * ldd + k0, ldd, scr, lane);
}
__device__ __forceinline__ void pro_row(const float* xrow, const float* g, bf16_t* orow, const float* wg, float* gates_out, int lane) {
    f32x4 v[8]; float ss = 0.f;
#pragma unroll
    for (int j = 0; j < 8; ++j) { v[j] = *(const f32x4*)(xrow + 4 * lane + 256 * j); ss += (v[j][0] * v[j][0] + v[j][1] * v[j][1]) + (v[j][2] * v[j][2] + v[j][3] * v[j][3]); }
    ss = wave_sum(ss); const float rstd = rsqrtf(ss * (1.f / DM) + EPS);
    f32x4 ga0 = {0.f, 0.f, 0.f, 0.f}, ga1 = {0.f, 0.f, 0.f, 0.f};
#pragma unroll
    for (int j = 0; j < 8; ++j) { const f32x4 gj = *(const f32x4*)(g + 4 * lane + 256 * j); v[j] = v[j] * rstd * gj;
        u32x2 w; w.x = cvt_pk_bf16(v[j][0], v[j][1]); w.y = cvt_pk_bf16(v[j][2], v[j][3]); *(u32x2*)(orow + 4 * lane + 256 * j) = w;
        if (wg) {
#pragma unroll
            for (int e = 0; e < 4; ++e) { const float* wp = wg + ((j * 4 + e) * 64 + lane) * 4; ga0 += v[j][e] * *(const f32x4*)wp; ga1 += v[j][e] * *(const f32x4*)(wp + 8192); } } }
    if (wg) {
#pragma unroll
        for (int q = 0; q < 4; ++q) { ga0[q] = wave_sum(ga0[q]); ga1[q] = wave_sum(ga1[q]); }
        if (lane == 0) { *(f32x4*)gates_out = ga0; *(f32x4*)(gates_out + 4) = ga1; } }
}
__device__ __forceinline__ void phase_prologue(const Args& a, unsigned char* lds_, int G) {
    const int tid = threadIdx.x, lane = tid & 63, wave = tid >> 6;
    LAS float* scr = (LAS float*)((LAS unsigned char*)lds_ + wave * 16640);
    const int gw = blockIdx.x * 8 + wave, NGW = G * 8;
    unsigned char* ws = a.ws;
    constexpr int I_IN = 32 * 80, I_SQ = 32 * 32, I_RG = 8 * 4;
    constexpr int NITEMS = I_IN + 2 * I_SQ + 2 * I_RG;
    for (int it = gw; it < NITEMS; it += NGW) {
        int r = it;
        if (r < I_IN) { tr_mat<0>(r, a.in[I_WIN], INW, ZW, (bf16_t*)(ws + WS_WIN), DM, scr, lane); continue; } r -= I_IN;
        if (r < I_SQ) { tr_mat<0>(r, a.in[I_WK], DM, DM, (bf16_t*)(ws + WS_WKV), DM, scr, lane); continue; } r -= I_SQ;
        if (r < I_SQ) { tr_mat<0>(r, a.in[I_WV], DM, DM, (bf16_t*)(ws + WS_WKV) + (size_t)DM * DM, DM, scr, lane); continue; } r -= I_SQ;
        if (r < I_RG) { const int blk = r >> 2; tr_mat<0>(r & 3, a.in[I_WRGA] + blk * 16384, 128, 128, (bf16_t*)(ws + WS_WRG) + blk * 32768, 128, scr, lane); continue; } r -= I_RG;
        { const int blk = r >> 2; tr_mat<0>(r & 3, a.in[I_WRGX] + blk * 16384, 128, 128, (bf16_t*)(ws + WS_WRG) + blk * 32768 + 128 * 128, 128, scr, lane); }
    }
    bf16_t* ABUF = (bf16_t*)(ws + WS_ABUF); float* GATES = (float*)(ws + WS_GATES);
    __syncthreads();
    float* wgl = (float*)lds_;
    for (int idx = tid; idx < 4096; idx += 512) { const int k = idx >> 1, hf = idx & 1; const int slot = ((k >> 8) * 4 + (k & 3)) * 64 + ((k & 255) >> 2);
        *(f32x4*)(wgl + hf * 8192 + slot * 4) = *(const f32x4*)(a.in[I_WIN] + (size_t)k * INW + ZW + hf * 4); }
    __syncthreads();
    for (int r = gw; r < MA; r += NGW) {
        if (r < MV) { const float* xrow = r < NP ? a.in[I_XP] + (size_t)r * DM : a.in[I_XS] + (size_t)(r - NP) * DM;
            pro_row(xrow, a.in[I_GMIX], ABUF + (size_t)r * DM, wgl, GATES + (size_t)r * 8, lane); }
        else {
#pragma unroll
            for (int j = 0; j < 8; ++j) *(u32x2*)(ABUF + (size_t)r * DM + 4 * lane + 256 * j) = (u32x2){0u, 0u}; }
    }
    for (int r = gw; r < 1024; r += NGW) pro_row(a.in[I_MEM] + (size_t)r * DM, a.in[I_GMEM], (bf16_t*)(ws + WS_MN) + (size_t)r * DM, nullptr, nullptr, lane);
}

constexpr int LATE_ITEMS = 3 * 32 * 88 + 3 * 32 * 32;
__device__ __forceinline__ void late_transposes(const Args& a, unsigned char* lds_, int first, int last, int wslot, int nslots) {
    const int lane = threadIdx.x & 63, wave = threadIdx.x >> 6;
    LAS float* scr = (LAS float*)((LAS unsigned char*)lds_ + wave * 16640);
    constexpr int I_GU = 32 * 88;
    for (int it = first + wslot; it < last; it += nslots) {
        int r = it;
        if (r < I_GU) { tr_mat<1>(r, a.in[I_WG], DFF, DFF, (bf16_t*)(a.ws + WS_WGU), DM, scr, lane); continue; } r -= I_GU;
        if (r < I_GU) { tr_mat<2>(r, a.in[I_WU], DFF, DFF, (bf16_t*)(a.ws + WS_WGU), DM, scr, lane); continue; } r -= I_GU;
        if (r < I_GU) { tr_mat<0>(r, a.in[I_WD], DM, DM, (bf16_t*)(a.ws + WS_WD), DFF, scr, lane); continue; } r -= I_GU;
        if (r < 1024) { tr_mat<0>(r, a.in[I_WOUT], DM, DM, (bf16_t*)(a.ws + WS_WOUT), DM, scr, lane); continue; } r -= 1024;
        if (r < 1024) { tr_mat<0>(r, a.in[I_WQ], DM, DM, (bf16_t*)(a.ws + WS_WQ), DM, scr, lane); continue; } r -= 1024;
        tr_mat<0>(r, a.in[I_WO], DM, DM, (bf16_t*)(a.ws + WS_WO), DM, scr, lane);
    }
}

__device__ __forceinline__ void unpack8(const u32x4 w, float* f) { f[0] = bflo(w.x); f[1] = bfhi(w.x); f[2] = bflo(w.y); f[3] = bfhi(w.y); f[4] = bflo(w.z); f[5] = bfhi(w.z); f[6] = bflo(w.w); f[7] = bfhi(w.w); }

__device__ __forceinline__ void rg_item(const Args& a, unsigned char* lds_, int b, int blk, int seg) {
    const int tid = threadIdx.x, lane = tid & 63, wave = tid >> 6;
    unsigned char* ws = a.ws;
    const bf16_t* Z = (const bf16_t*)(ws + WS_Z); float* YPRE = (float*)(ws + WS_YPRE); float* CPRE = (float*)(ws + WS_CPRE); float* RGE = (float*)(ws + WS_RGE);
    bf16_t* XRb = (bf16_t*)lds_;
    float* XRf = (float*)(lds_ + 17408);
    float* Gs = (float*)(lds_ + 17408 + 32768);
    bf16x8 bfr[2][4];
    { const bf16_t* wrg = (const bf16_t*)(ws + WS_WRG) + blk * 32768;
#pragma unroll
      for (int nt = 0; nt < 2; ++nt)
#pragma unroll
          for (int ks = 0; ks < 4; ++ks) bfr[nt][ks] = *(const bf16x8*)(wrg + (wave * 32 + nt * 16 + (lane & 15)) * 128 + ks * 32 + (lane >> 4) * 8); }
    const int c8 = tid & 15, chb = blk * 128 + c8 * 8;
    float cw[4][8], cb[8];
#pragma unroll
    for (int e = 0; e < 8; ++e) { cb[e] = a.in[I_CONVB][chb + e];
#pragma unroll
        for (int j = 0; j < 4; ++j) cw[j][e] = a.in[I_CONVW][j * 1024 + chb + e]; }
    float bias[2];
#pragma unroll
    for (int nt = 0; nt < 2; ++nt) { const int col = wave * 32 + nt * 16 + (lane & 15); bias[nt] = col < 128 ? a.in[I_BRGA][blk * 128 + col] : a.in[I_BRGX][blk * 128 + col - 128]; }
    const int cc = tid & 127;
    float sp; { const float nl = -a.in[I_LAM][blk * 128 + cc]; sp = nl > 20.f ? nl : log1pf(__expf(nl)); }
    float hcar = 0.f, pcar = 1.f;
    u32x4 zpre[2][4];
    { const int t0 = seg * 512;
#pragma unroll
      for (int i = 0; i < 2; ++i)
#pragma unroll
          for (int j = 0; j < 4; ++j) { const int tt = t0 + ((tid + 512 * i) >> 4) - 3 + j; zpre[i][j] = tt >= 0 ? *(const u32x4*)(Z + ((size_t)b * SEQ + tt) * ZW + chb) : (u32x4){0u, 0u, 0u, 0u}; } }
    for (int tile = 0; tile < 8; ++tile) {
        const int t0 = seg * 512 + tile * 64; const size_t R0 = (size_t)b * SEQ + t0;
#pragma unroll
        for (int i = 0; i < 2; ++i) { const int t = (tid + 512 * i) >> 4; float xr[8];
#pragma unroll
            for (int e = 0; e < 8; ++e) xr[e] = cb[e];
#pragma unroll
            for (int j = 0; j < 4; ++j) { float z[8]; unpack8(zpre[i][j], z);
#pragma unroll
                for (int e = 0; e < 8; ++e) xr[e] += cw[j][e] * z[e]; }
            *(f32x4*)(XRf + t * 128 + c8 * 8) = (f32x4){xr[0], xr[1], xr[2], xr[3]}; *(f32x4*)(XRf + t * 128 + c8 * 8 + 4) = (f32x4){xr[4], xr[5], xr[6], xr[7]};
            u32x4 w; w.x = cvt_pk_bf16(xr[0], xr[1]); w.y = cvt_pk_bf16(xr[2], xr[3]); w.z = cvt_pk_bf16(xr[4], xr[5]); w.w = cvt_pk_bf16(xr[6], xr[7]);
            *(u32x4*)(XRb + t * 136 + c8 * 8) = w; }
        if (tile < 7) {
#pragma unroll
            for (int i = 0; i < 2; ++i)
#pragma unroll
                for (int j = 0; j < 4; ++j) { const int tt = t0 + 64 + ((tid + 512 * i) >> 4) - 3 + j; zpre[i][j] = *(const u32x4*)(Z + ((size_t)b * SEQ + tt) * ZW + chb); } }
        LBAR();
        { f32x4 acc[4][2];
#pragma unroll
          for (int mt = 0; mt < 4; ++mt)
#pragma unroll
              for (int nt = 0; nt < 2; ++nt) acc[mt][nt] = (f32x4){0.f, 0.f, 0.f, 0.f};
#pragma unroll
          for (int mt = 0; mt < 4; ++mt)
#pragma unroll
              for (int ks = 0; ks < 4; ++ks) { const bf16x8 af = *(const bf16x8*)(XRb + (mt * 16 + (lane & 15)) * 136 + ks * 32 + (lane >> 4) * 8);
#pragma unroll
                  for (int nt = 0; nt < 2; ++nt) acc[mt][nt] = __builtin_amdgcn_mfma_f32_16x16x32_bf16(af, bfr[nt][ks], acc[mt][nt], 0, 0, 0); }
#pragma unroll
          for (int mt = 0; mt < 4; ++mt)
#pragma unroll
              for (int nt = 0; nt < 2; ++nt)
#pragma unroll
                  for (int j = 0; j < 4; ++j) Gs[(mt * 16 + (lane >> 4) * 4 + j) * 256 + wave * 32 + nt * 16 + (lane & 15)] = sigmoidf_(acc[mt][nt][j] + bias[nt]); }
        LBAR();
#pragma unroll 4
        for (int i = 0; i < 16; ++i) { const int t = (tid + 512 * i) >> 7; const float r = Gs[t * 256 + cc], ig = Gs[t * 256 + 128 + cc];
            const float la = -8.f * r * sp, av = __expf(la), mult = sqrtf(fmaxf(1.f - __expf(2.f * la), 0.f));
            Gs[t * 256 + cc] = av; Gs[t * 256 + 128 + cc] = mult * ig * XRf[t * 128 + cc]; }
        LBAR();
        if (tid < 128) {
#pragma unroll 8
            for (int t = 0; t < 64; ++t) { const float av = Gs[t * 256 + tid]; hcar = av * hcar + Gs[t * 256 + 128 + tid]; pcar *= av; Gs[t * 256 + tid] = hcar; Gs[t * 256 + 128 + tid] = pcar; } }
        LBAR();
#pragma unroll
        for (int i = 0; i < 2; ++i) { const int t = (tid + 512 * i) >> 4; const float* gp = Gs + t * 256 + c8 * 8;
            float* yp = YPRE + (R0 + t) * 1024 + chb; *(f32x4*)yp = *(const f32x4*)gp; *(f32x4*)(yp + 4) = *(const f32x4*)(gp + 4);
            float* pp = CPRE + (R0 + t) * 1024 + chb; *(f32x4*)pp = *(const f32x4*)(gp + 128); *(f32x4*)(pp + 4) = *(const f32x4*)(gp + 132); }
    }
    if (tid < 128) { RGE[((size_t)(b * 4 + seg) * 2 + 0) * 1024 + blk * 128 + tid] = hcar; RGE[((size_t)(b * 4 + seg) * 2 + 1) * 1024 + blk * 128 + tid] = pcar; }
    if (seg == 3 && tid < 384) { const int j = tid >> 7, c = tid & 127; a.out[O_PRGC + ((size_t)b * 3 + j) * 1024 + blk * 128 + c] = bf2f(Z[((size_t)b * SEQ + 2045 + j) * ZW + blk * 128 + c]); }
    __syncthreads();
}

__device__ __forceinline__ void ml_item(const Args& a, unsigned char* lds_, int b, int h, int sl, int seg) {
    const int tid = threadIdx.x, lane = tid & 63, wave = tid >> 6, l15 = lane & 15, lq = lane >> 4;
    unsigned char* ws = a.ws;
    const bf16_t* Z = (const bf16_t*)(ws + WS_Z); const float* GATES = (const float*)(ws + WS_GATES); float* HPRE = (float*)(ws + WS_HPRE); float* MLS = (float*)(ws + WS_MLS);
    bf16_t* Qs = (bf16_t*)lds_;
    bf16_t* Ks = (bf16_t*)(lds_ + 17408);
    bf16_t* Vt = (bf16_t*)(lds_ + 34816);
    bf16_t* Kwt = (bf16_t*)(lds_ + 46336);
    bf16_t* Ss = (bf16_t*)(lds_ + 64768);
    bf16_t* Ctb = (bf16_t*)(lds_ + 73984);
    float* Out = (float*)(lds_ + 95744);
    float* Aa = (float*)(lds_ + 116480);
    float* Am = Aa + 2048;
    float* Bc = Am + 2048;
    const float scale = 0.08838834764831845f;
    for (int i = tid; i < 80 * 136; i += 512) Ctb[i] = 0;
    for (int i = tid; i < 16 * 72; i += 512) Vt[64 * 72 + i] = (i < 72) ? (bf16_t)0x3F80 : (bf16_t)0;
    { const float bi = a.in[I_BMLI][h], bff = a.in[I_BMLF][h];
#pragma unroll
      for (int cI = 0; cI < 4; ++cI) { const int tok = (wave + 8 * cI) * 64 + lane; const size_t R = (size_t)b * SEQ + tok;
          const float gi = GATES[R * 8 + h] + bi, gf = GATES[R * 8 + 4 + h] + bff;
          const float lf = fminf(gf, 0.f) - log1pf(__expf(-fabsf(gf)));
          float bc = lf;
#pragma unroll
          for (int o = 1; o < 64; o <<= 1) { const float t = __shfl_up(bc, o); if (lane >= o) bc += t; }
          const float av = gi - bc; float am = av;
#pragma unroll
          for (int o = 1; o < 64; o <<= 1) { const float t = __shfl_up(am, o); if (lane >= o) am = fmaxf(am, t); }
          Aa[tok] = av; Am[tok] = am; Bc[tok] = bc; } }
    f32x4 cacc[5];
#pragma unroll
    for (int mt = 0; mt < 5; ++mt) cacc[mt] = (f32x4){0.f, 0.f, 0.f, 0.f};
    float m_prev = 0.f, m_old = 0.f, m_seg = 0.f, Fs = 0.f, Fs_old = 0.f;
    const int pt = tid & 63, pd8 = tid >> 6;
    u32x4 qpre[2], kpre[2], vpre;
#define ML_LOAD(Q, K, V, R0_) do { _Pragma("unroll") for (int i = 0; i < 2; ++i) { Q[i] = *(const u32x4*)(Z + ((R0_) + pt) * ZW + 2048 + h * 128 + (2 * pd8 + i) * 8); K[i] = *(const u32x4*)(Z + ((R0_) + pt) * ZW + 2560 + h * 128 + (2 * pd8 + i) * 8); } \
        V = *(const u32x4*)(Z + ((R0_) + pt) * ZW + 3072 + h * 256 + sl * 64 + pd8 * 8); } while (0)
    { const size_t R0 = (size_t)b * SEQ + seg * 1024; ML_LOAD(qpre, kpre, vpre, R0); }
    __syncthreads();
    for (int c = 0; c < seg * 16; ++c) m_prev = Bc[c * 64 + 63] + fmaxf(m_prev, Am[c * 64 + 63]);
    m_seg = m_prev; m_old = m_prev;
#pragma unroll 1
    for (int ci = 0; ci <= 16; ++ci) {
        const int ch = seg * 16 + ci, c0 = ch * 64;
        const int cq = ci < 16 ? c0 : 0; const float F = Bc[cq + 63], m_new = F + fmaxf(m_prev, Am[cq + 63]), dec = __expf(F + m_prev - m_new);
        if (ci < 16) { const float wend = __expf(F + Aa[c0 + pt] - m_new) * scale;
#pragma unroll
          for (int i = 0; i < 2; ++i) { const int d8 = 2 * pd8 + i;
              *(u32x4*)(Qs + pt * 136 + d8 * 8) = qpre[i]; *(u32x4*)(Ks + pt * 136 + d8 * 8) = kpre[i];
              float kf[8]; unpack8(kpre[i], kf); bf16_t* kp = Kwt + (d8 * 8) * 72 + pt;
#pragma unroll
              for (int e = 0; e < 8; ++e) kp[e * 72] = f2bf(kf[e] * wend); }
          bf16_t* vp = Vt + (pd8 * 8) * 72 + pt; const u32x4 w = vpre;
          vp[0] = (bf16_t)(w.x & 0xffff); vp[72] = (bf16_t)(w.x >> 16); vp[144] = (bf16_t)(w.y & 0xffff); vp[216] = (bf16_t)(w.y >> 16);
          vp[288] = (bf16_t)(w.z & 0xffff); vp[360] = (bf16_t)(w.z >> 16); vp[432] = (bf16_t)(w.w & 0xffff); vp[504] = (bf16_t)(w.w >> 16); }
        if (ci > 0) { const size_t R1 = (size_t)b * SEQ + c0 - 64;
#pragma unroll
            for (int mt = 0; mt < 5; ++mt)
#pragma unroll
                for (int j = 0; j < 4; ++j) Ctb[(mt * 16 + lq * 4 + j) * 136 + wave * 16 + l15] = f2bf(cacc[mt][j]);
#pragma unroll
            for (int i = 0; i < 8; ++i) { const int idx = tid + 512 * i, v = idx & 63, t = idx >> 6; HPRE[(R1 + t) * 1024 + h * 256 + sl * 64 + v] = Out[t * 81 + v]; }
            if (sl == 0 && tid < 64) { const int t = tid; const float mtv = Bc[c0 - 64 + t] + fmaxf(m_old, Am[c0 - 64 + t]);
                f32x4 o; o[0] = Out[t * 81 + 64]; o[1] = __expf(-mtv); o[2] = seg ? __expf(Fs_old + Bc[c0 - 64 + t] + m_seg - mtv) : 0.f; o[3] = 0.f;
                *(f32x4*)(MLS + ((R1 + t) * 4 + h) * 4) = o; } }
        if (ci == 16) break;
        if (ci < 15) { const size_t R0 = (size_t)b * SEQ + c0 + 64; ML_LOAD(qpre, kpre, vpre, R0); }
        LBAR();
        { const int mt = wave >> 1; bf16x8 afq[4]; f32x4 acc2[2] = {{0.f, 0.f, 0.f, 0.f}, {0.f, 0.f, 0.f, 0.f}};
#pragma unroll
          for (int ks = 0; ks < 4; ++ks) afq[ks] = *(const bf16x8*)(Qs + (mt * 16 + l15) * 136 + ks * 32 + lq * 8);
#pragma unroll
          for (int ks = 0; ks < 4; ++ks)
#pragma unroll
              for (int n = 0; n < 2; ++n) { const int nt = 2 * (wave & 1) + n; const bf16x8 bfv = *(const bf16x8*)(Ks + (nt * 16 + l15) * 136 + ks * 32 + lq * 8);
                  acc2[n] = __builtin_amdgcn_mfma_f32_16x16x32_bf16(afq[ks], bfv, acc2[n], 0, 0, 0); }
#pragma unroll
          for (int n = 0; n < 2; ++n) { const int nt = 2 * (wave & 1) + n; const int sI = nt * 16 + l15; const float as = Aa[c0 + sI];
#pragma unroll
              for (int j = 0; j < 4; ++j) { const int t = mt * 16 + lq * 4 + j; const float v = (sI <= t) ? acc2[n][j] * scale * __expf(as - fmaxf(m_prev, Am[c0 + t])) : 0.f; Ss[t * 72 + sI] = f2bf(v); } } }
        LBAR();
        { const int mt = wave & 3, nt0 = wave < 4 ? 0 : 3, nn = wave < 4 ? 3 : 2; bf16x8 afq[4], afs[2]; f32x4 acc3[3];
#pragma unroll
          for (int n = 0; n < 3; ++n) acc3[n] = (f32x4){0.f, 0.f, 0.f, 0.f};
#pragma unroll
          for (int ks = 0; ks < 4; ++ks) afq[ks] = *(const bf16x8*)(Qs + (mt * 16 + l15) * 136 + ks * 32 + lq * 8);
#pragma unroll
          for (int ks = 0; ks < 2; ++ks) afs[ks] = *(const bf16x8*)(Ss + (mt * 16 + l15) * 72 + ks * 32 + lq * 8);
#pragma unroll
          for (int ks = 0; ks < 4; ++ks)
#pragma unroll
              for (int n = 0; n < 3; ++n) if (n < nn) { const bf16x8 bfv = *(const bf16x8*)(Ctb + ((nt0 + n) * 16 + l15) * 136 + ks * 32 + lq * 8);
                  acc3[n] = __builtin_amdgcn_mfma_f32_16x16x32_bf16(afq[ks], bfv, acc3[n], 0, 0, 0); }
          float scv[4];
#pragma unroll
          for (int j = 0; j < 4; ++j) scv[j] = __expf(m_prev - fmaxf(m_prev, Am[c0 + mt * 16 + lq * 4 + j]));
#pragma unroll
          for (int n = 0; n < 3; ++n)
#pragma unroll
              for (int j = 0; j < 4; ++j) acc3[n][j] *= scv[j];
#pragma unroll
          for (int ks = 0; ks < 2; ++ks)
#pragma unroll
              for (int n = 0; n < 3; ++n) if (n < nn) { const bf16x8 bfv = *(const bf16x8*)(Vt + ((nt0 + n) * 16 + l15) * 72 + ks * 32 + lq * 8);
                  acc3[n] = __builtin_amdgcn_mfma_f32_16x16x32_bf16(afs[ks], bfv, acc3[n], 0, 0, 0); }
#pragma unroll
          for (int n = 0; n < 3; ++n) if (n < nn) {
#pragma unroll
              for (int j = 0; j < 4; ++j) Out[(mt * 16 + lq * 4 + j) * 81 + (nt0 + n) * 16 + l15] = acc3[n][j]; } }
#pragma unroll
        for (int mt = 0; mt < 5; ++mt) { cacc[mt] = cacc[mt] * dec;
#pragma unroll
            for (int ks = 0; ks < 2; ++ks) { const bf16x8 af = *(const bf16x8*)(Vt + (mt * 16 + l15) * 72 + ks * 32 + lq * 8), bfv = *(const bf16x8*)(Kwt + (wave * 16 + l15) * 72 + ks * 32 + lq * 8);
                cacc[mt] = __builtin_amdgcn_mfma_f32_16x16x32_bf16(af, bfv, cacc[mt], 0, 0, 0); } }
        m_old = m_prev; m_prev = m_new; Fs_old = Fs; Fs += F;
        LBAR();
    }
#undef ML_LOAD
    if (seg == 0) {
        float* CINF = (float*)(ws + WS_CINF) + (size_t)((b * 4 + h) * 4 + sl) * 80 * 128; bf16_t* CIN = (bf16_t*)(ws + WS_CIN) + (size_t)((b * 4 + h) * 4 + sl) * 80 * 128;
#pragma unroll
        for (int mt = 0; mt < 5; ++mt)
#pragma unroll
            for (int j = 0; j < 4; ++j) { const int o = (mt * 16 + lq * 4 + j) * 128 + wave * 16 + l15; CINF[o] = cacc[mt][j]; CIN[o] = f2bf(cacc[mt][j]); }
    } else {
#pragma unroll
        for (int mt = 0; mt < 4; ++mt)
#pragma unroll
            for (int j = 0; j < 4; ++j) a.out[O_PMLC + ((size_t)((b * 4 + h) * 128 + wave * 16 + l15)) * 256 + sl * 64 + mt * 16 + lq * 4 + j] = cacc[mt][j];
        if (sl == 0) { if (lq == 0) a.out[O_PMLN + (size_t)(b * 4 + h) * 128 + wave * 16 + l15] = cacc[4][0];
            if (tid == 0) { a.out[O_PMLM + b * 4 + h] = m_prev; ((float*)(ws + WS_GL))[b * 4 + h] = __expf(Fs + m_seg - m_prev); } }
    }
    __syncthreads();
}

__device__ __forceinline__ void sample_item(const Args& a, unsigned char* lds_, int b) {
    const int tid = threadIdx.x, lane = tid & 63, wave = tid >> 6;
    unsigned char* ws = a.ws;
    const size_t r = (size_t)NP + b;
    const bf16_t* Zr = (const bf16_t*)(ws + WS_Z) + r * ZW; const float* GATES = (const float*)(ws + WS_GATES) + r * 8;
    float* YPRE = (float*)(ws + WS_YPRE) + r * 1024; float* HPRE = (float*)(ws + WS_HPRE) + r * 1024;
    float* xr = (float*)lds_;
    float* gpre = xr + 1024;
    float* qs = gpre + 2048;
    float* ks = qs + 128;
    float* vs = ks + 128;
    float* red = vs + 256;
    float* dn = red + 2048;
#pragma unroll
    for (int i = 0; i < 2; ++i) { const int c = tid + 512 * i; const float zx = bf2f(Zr[c]);
        const float b0 = a.in[I_SRGC][((size_t)b * 3 + 0) * 1024 + c], b1 = a.in[I_SRGC][((size_t)b * 3 + 1) * 1024 + c], b2 = a.in[I_SRGC][((size_t)b * 3 + 2) * 1024 + c];
        xr[c] = a.in[I_CONVB][c] + a.in[I_CONVW][c] * b0 + a.in[I_CONVW][1024 + c] * b1 + a.in[I_CONVW][2048 + c] * b2 + a.in[I_CONVW][3072 + c] * zx;
        a.out[O_SRGC + ((size_t)b * 3 + 0) * 1024 + c] = b1; a.out[O_SRGC + ((size_t)b * 3 + 1) * 1024 + c] = b2; a.out[O_SRGC + ((size_t)b * 3 + 2) * 1024 + c] = zx; }
    __syncthreads();
    { const int mat = tid >> 8, q = tid & 255, blk = q >> 5, d4 = (q & 31) * 4;
      const float* W = (mat ? a.in[I_WRGX] : a.in[I_WRGA]) + blk * 16384 + d4; const float* xb = xr + blk * 128;
      f32x4 acc = *(const f32x4*)((mat ? a.in[I_BRGX] : a.in[I_BRGA]) + blk * 128 + d4);
#pragma unroll 1
      for (int k0 = 0; k0 < 128; k0 += 16) { f32x4 w[16];
#pragma unroll
          for (int k = 0; k < 16; ++k) w[k] = *(const f32x4*)(W + (size_t)(k0 + k) * 128);
#pragma unroll
          for (int k = 0; k < 16; ++k) acc += w[k] * xb[k0 + k]; }
      *(f32x4*)(gpre + mat * 1024 + blk * 128 + d4) = acc; }
    __syncthreads();
#pragma unroll
    for (int i = 0; i < 2; ++i) { const int c = tid + 512 * i;
        const float rg = sigmoidf_(gpre[c]), ig = sigmoidf_(gpre[1024 + c]); const float nl = -a.in[I_LAM][c]; const float sp = nl > 20.f ? nl : log1pf(__expf(nl));
        const float la = -8.f * rg * sp, av = __expf(la), mult = sqrtf(fmaxf(1.f - __expf(2.f * la), 0.f));
        const float hv = av * a.in[I_SRGH][(size_t)b * 1024 + c] + mult * (ig * xr[c]);
        a.out[O_SRGH + (size_t)b * 1024 + c] = hv; YPRE[c] = hv * gelu_tanh(bf2f(Zr[1024 + c])); }
    for (int h = 0; h < 4; ++h) {
        const float* C0 = a.in[I_SMLC] + (size_t)(b * 4 + h) * 128 * 256; float* C1 = a.out + O_SMLC + (size_t)(b * 4 + h) * 128 * 256;
        f32x4 c0[16];
#pragma unroll
        for (int i = 0; i < 16; ++i) c0[i] = *(const f32x4*)(C0 + (size_t)(wave + 8 * i) * 256 + 4 * lane);
        __syncthreads();
        if (tid < 128) { qs[tid] = bf2f(Zr[2048 + h * 128 + tid]); ks[tid] = bf2f(Zr[2560 + h * 128 + tid]) * 0.08838834764831845f; }
        else if (tid < 384) vs[tid - 128] = bf2f(Zr[3072 + h * 256 + tid - 128]);
        const float li = GATES[h] + a.in[I_BMLI][h], gf = GATES[4 + h] + a.in[I_BMLF][h]; const float lf = fminf(gf, 0.f) - log1pf(__expf(-fabsf(gf)));
        const float m0 = a.in[I_SMLM][b * 4 + h]; const float m_new = fmaxf(lf + m0, li), sc = __expf(lf + m0 - m_new), Dv = __expf(li - m_new);
        __syncthreads();
        f32x4 num = {0.f, 0.f, 0.f, 0.f}; const f32x4 v4 = *(const f32x4*)(vs + 4 * lane);
#pragma unroll
        for (int i = 0; i < 16; ++i) { const int d = wave + 8 * i; const f32x4 cn = c0[i] * sc + v4 * (Dv * ks[d]);
            *(f32x4*)(C1 + (size_t)d * 256 + 4 * lane) = cn; num += cn * qs[d]; }
        *(f32x4*)(red + wave * 256 + 4 * lane) = num;
        if (tid < 128) { const float nn = sc * a.in[I_SMLN][(size_t)(b * 4 + h) * 128 + tid] + Dv * ks[tid]; a.out[O_SMLN + (size_t)(b * 4 + h) * 128 + tid] = nn; dn[tid] = nn * qs[tid]; }
        if (tid == 0) a.out[O_SMLM + b * 4 + h] = m_new;
        __syncthreads();
        if (tid < 256) { float den = 0.f;
#pragma unroll 8
            for (int k = 0; k < 128; ++k) den += dn[k];
            den = fmaxf(fabsf(den), __expf(-m_new)); float nv = 0.f;
#pragma unroll
            for (int w = 0; w < 8; ++w) nv += red[w * 256 + tid];
            HPRE[h * 256 + tid] = nv / den; }
    }
    __syncthreads();
}

__device__ __forceinline__ void fin_row(const Args& a, int r, const float* hin, int lane, bool mlnorm) {
    unsigned char* ws = a.ws; const bf16_t* Z = (const bf16_t*)(ws + WS_Z); const float* YPRE = (const float*)(ws + WS_YPRE); const float* CPRE = (const float*)(ws + WS_CPRE);
    const float* HPRE = (const float*)(ws + WS_HPRE); bf16_t* YMIX = (bf16_t*)(ws + WS_YMIX);
    f32x4 y[4]; float ss = 0.f;
#pragma unroll
    for (int j = 0; j < 4; ++j) { y[j] = *(const f32x4*)(YPRE + (size_t)r * 1024 + 4 * lane + 256 * j);
        if (hin) { const f32x4 p = *(const f32x4*)(CPRE + (size_t)r * 1024 + 4 * lane + 256 * j), hi = *(const f32x4*)(hin + 4 * lane + 256 * j);
            const u32x2 zg = *(const u32x2*)(Z + (size_t)r * ZW + 1024 + 4 * lane + 256 * j); y[j] = y[j] + p * hi;
            y[j][0] *= gelu_tanh(bflo(zg.x)); y[j][1] *= gelu_tanh(bfhi(zg.x)); y[j][2] *= gelu_tanh(bflo(zg.y)); y[j][3] *= gelu_tanh(bfhi(zg.y)); }
        ss += (y[j][0] * y[j][0] + y[j][1] * y[j][1]) + (y[j][2] * y[j][2] + y[j][3] * y[j][3]); }
    ss = wave_sum(ss); const float rs = rsqrtf(ss * (1.f / 1024.f) + EPS);
#pragma unroll
    for (int j = 0; j < 4; ++j) { const f32x4 gg = *(const f32x4*)(a.in[I_GRG] + 4 * lane + 256 * j); const f32x4 o = y[j] * rs * gg;
        u32x2 w; w.x = cvt_pk_bf16(o[0], o[1]); w.y = cvt_pk_bf16(o[2], o[3]); *(u32x2*)(YMIX + (size_t)r * DM + 4 * lane + 256 * j) = w; }
#pragma unroll
    for (int j = 0; j < 4; ++j) { f32x4 hv = *(const f32x4*)(HPRE + (size_t)r * 1024 + j * 256 + 4 * lane);
        if (mlnorm) { const f32x4 ms = *(const f32x4*)((const float*)(ws + WS_MLS) + ((size_t)r * 4 + j) * 4); hv = hv * (1.f / fmaxf(fabsf(ms[0]), ms[1])); }
        const float s2 = wave_sum((hv[0] * hv[0] + hv[1] * hv[1]) + (hv[2] * hv[2] + hv[3] * hv[3])); const float r2 = rsqrtf(s2 * (1.f / 256.f) + EPS);
        const f32x4 gg = *(const f32x4*)(a.in[I_GML] + j * 256 + 4 * lane); const u32x2 zo = *(const u32x2*)(Z + (size_t)r * ZW + 4096 + j * 256 + 4 * lane);
        f32x4 o = hv * r2 * gg; o[0] *= sigmoidf_(bflo(zo.x)); o[1] *= sigmoidf_(bfhi(zo.x)); o[2] *= sigmoidf_(bflo(zo.y)); o[3] *= sigmoidf_(bfhi(zo.y));
        u32x2 w; w.x = cvt_pk_bf16(o[0], o[1]); w.y = cvt_pk_bf16(o[2], o[3]); *(u32x2*)(YMIX + (size_t)r * DM + 1024 + j * 256 + 4 * lane) = w; }
}
__device__ __forceinline__ void phase_finalize(const Args& a, unsigned char* lds_, int G) {
    const int tid = threadIdx.x, lane = tid & 63, wave = tid >> 6;
    const float* RGE = (const float*)(a.ws + WS_RGE); float* hin = (float*)lds_;
    for (int g = blockIdx.x; g < 256; g += G) {
        const int b = g >> 6, seg = (g >> 4) & 3;
        for (int c = tid; c < 1024; c += 512) { float hh = 0.f;
            for (int q = 0; q < seg; ++q) hh = RGE[((size_t)(b * 4 + q) * 2 + 0) * 1024 + c] + RGE[((size_t)(b * 4 + q) * 2 + 1) * 1024 + c] * hh;
            hin[c] = hh;
            if ((g & 63) == 63) a.out[O_PRGH + (size_t)b * 1024 + c] = RGE[((size_t)(b * 4 + 3) * 2 + 0) * 1024 + c] + RGE[((size_t)(b * 4 + 3) * 2 + 1) * 1024 + c] * hh; }
        if ((g & 63) >= 32) {
            const int hh = wave >> 1, mt = wave & 1, l15 = lane & 15, lq = lane >> 4, r0 = g * 32;
            const bf16_t* Z = (const bf16_t*)(a.ws + WS_Z); float* HPRE = (float*)(a.ws + WS_HPRE); float* MLS = (float*)(a.ws + WS_MLS);
            bf16x8 afq[4]; float gj[4];
#pragma unroll
            for (int ks = 0; ks < 4; ++ks) afq[ks] = *(const bf16x8*)(Z + (size_t)(r0 + mt * 16 + l15) * ZW + 2048 + hh * 128 + ks * 32 + lq * 8);
#pragma unroll
            for (int j = 0; j < 4; ++j) gj[j] = MLS[((size_t)(r0 + mt * 16 + lq * 4 + j) * 4 + hh) * 4 + 2];
            float* hp = HPRE + (size_t)(r0 + mt * 16 + lq * 4) * 1024 + hh * 256 + l15;
#pragma unroll 1
            for (int sl = 0; sl < 4; ++sl) { const bf16_t* cin = (const bf16_t*)(a.ws + WS_CIN) + (size_t)((b * 4 + hh) * 4 + sl) * 80 * 128;
                float old[4][4]; f32x4 acc[4];
#pragma unroll
                for (int nt = 0; nt < 4; ++nt)
#pragma unroll
                    for (int j = 0; j < 4; ++j) old[nt][j] = hp[(size_t)j * 1024 + sl * 64 + nt * 16];
#pragma unroll
                for (int nt = 0; nt < 4; ++nt) { acc[nt] = (f32x4){0.f, 0.f, 0.f, 0.f};
#pragma unroll
                    for (int ks = 0; ks < 4; ++ks) { const bf16x8 bfv = *(const bf16x8*)(cin + (nt * 16 + l15) * 128 + ks * 32 + lq * 8); acc[nt] = __builtin_amdgcn_mfma_f32_16x16x32_bf16(afq[ks], bfv, acc[nt], 0, 0, 0); } }
#pragma unroll
                for (int nt = 0; nt < 4; ++nt)
#pragma unroll
                    for (int j = 0; j < 4; ++j) hp[(size_t)j * 1024 + sl * 64 + nt * 16] = old[nt][j] + gj[j] * acc[nt][j];
                if (sl == 0) { f32x4 an = {0.f, 0.f, 0.f, 0.f};
#pragma unroll
                    for (int ks = 0; ks < 4; ++ks) { const bf16x8 bfv = *(const bf16x8*)(cin + (64 + l15) * 128 + ks * 32 + lq * 8); an = __builtin_amdgcn_mfma_f32_16x16x32_bf16(afq[ks], bfv, an, 0, 0, 0); }
                    if (l15 == 0) {
#pragma unroll
                        for (int j = 0; j < 4; ++j) MLS[((size_t)(r0 + mt * 16 + lq * 4 + j) * 4 + hh) * 4] += gj[j] * an[j]; } } }
        }
        __syncthreads();
        for (int rr = wave; rr < 32; rr += 8) fin_row(a, g * 32 + rr, hin, lane, true);
        __syncthreads();
    }
    {
        const float* CINF = (const float*)(a.ws + WS_CINF); const float* GL = (const float*)(a.ws + WS_GL);
        for (int idx = blockIdx.x * 512 + tid; idx < 16 * 128 * 256; idx += G * 512) { const int bh = idx >> 15, d = (idx >> 8) & 127, v = idx & 255;
            a.out[O_PMLC + idx] += GL[bh] * CINF[((size_t)(bh * 4 + (v >> 6)) * 80 + (v & 63)) * 128 + d]; }
        for (int idx = blockIdx.x * 512 + tid; idx < 16 * 128; idx += G * 512) { const int bh = idx >> 7, d = idx & 127;
            a.out[O_PMLN + idx] += GL[bh] * CINF[((size_t)(bh * 4) * 80 + 64) * 128 + d]; }
    }
    for (int j = blockIdx.x; j < NS; j += G) {
        if (wave == 0) fin_row(a, NP + j, nullptr, lane, false);
        if (wave == 1) {
#pragma unroll
            for (int q = 0; q < 8; ++q) *(u32x2*)((bf16_t*)(a.ws + WS_YMIX) + (size_t)(MV + j) * DM + 4 * lane + 256 * q) = (u32x2){0u, 0u}; }
    }
}

__device__ __forceinline__ void sattn_item(const Args& a, unsigned char* lds_, int b, int h) {
    const int tid = threadIdx.x, lane = tid & 63, wave = tid >> 6;
    unsigned char* ws = a.ws;
    float* SC = (float*)lds_;
    float* RED = SC + 1024;
    float q[8];
    { f32x4 q0 = {0.f, 0.f, 0.f, 0.f}, q1 = {0.f, 0.f, 0.f, 0.f}; const float* qp = (const float*)(ws + WS_P4) + (size_t)b * DM + h * 512 + lane * 8;
#pragma unroll
      for (int k = 0; k < 8; ++k) { q0 += *(const f32x4*)(qp + (size_t)k * NS * DM); q1 += *(const f32x4*)(qp + (size_t)k * NS * DM + 4); }
#pragma unroll
      for (int e = 0; e < 4; ++e) { q[e] = q0[e] * 0.04419417382415922f; q[4 + e] = q1[e] * 0.04419417382415922f; } }
    const float* kb = a.in[I_CK] + ((size_t)b * NMEM * 4 + h) * 512 + lane * 8; const float* vb = a.in[I_CV] + ((size_t)b * NMEM * 4 + h) * 512 + lane * 8;
    float mys = 0.f;
#pragma unroll 8
    for (int mm = 0; mm < 32; ++mm) { const float* p = kb + (size_t)(wave * 32 + mm) * DM; const f32x4 k0 = __builtin_nontemporal_load((const f32x4*)p), k1 = __builtin_nontemporal_load((const f32x4*)(p + 4));
        float d = (k0[0] * q[0] + k0[1] * q[1]) + (k0[2] * q[2] + k0[3] * q[3]) + (k1[0] * q[4] + k1[1] * q[5]) + (k1[2] * q[6] + k1[3] * q[7]);
        d = wave_sum(d); if (lane == mm) mys = d; }
    if (lane < 32) SC[wave * 32 + lane] = mys;
    __syncthreads();
    const float s0 = SC[lane], s1 = SC[64 + lane], s2 = SC[128 + lane], s3 = SC[192 + lane];
    const float mx = wave_max(fmaxf(fmaxf(s0, s1), fmaxf(s2, s3)));
    const float tot = wave_sum((__expf(s0 - mx) + __expf(s1 - mx)) + (__expf(s2 - mx) + __expf(s3 - mx)));
    f32x4 o0 = {0.f, 0.f, 0.f, 0.f}, o1 = {0.f, 0.f, 0.f, 0.f};
#pragma unroll 8
    for (int mm = 0; mm < 32; ++mm) { const int m = wave * 32 + mm; const float* p = vb + (size_t)m * DM; const float pr = __expf(SC[m] - mx);
        o0 += pr * __builtin_nontemporal_load((const f32x4*)p); o1 += pr * __builtin_nontemporal_load((const f32x4*)(p + 4)); }
    *(f32x4*)(RED + wave * 512 + lane * 8) = o0; *(f32x4*)(RED + wave * 512 + lane * 8 + 4) = o1;
    __syncthreads();
    { float s = 0.f;
#pragma unroll
      for (int w = 0; w < 8; ++w) s += RED[w * 512 + tid];
      ((bf16_t*)(ws + WS_OB))[((size_t)NP + b) * DM + h * 512 + tid] = f2bf(s / tot); }
    __syncthreads();
}

__device__ __forceinline__ void sample_prep(const float* X, const float* Pp, int nks, const float* g, bf16_t* Aout, float* Xnext, int lane) {
    f32x4 v[8]; float ss = 0.f;
#pragma unroll
    for (int j = 0; j < 8; ++j) { v[j] = *(const f32x4*)(X + 4 * lane + 256 * j);
        for (int k = 0; k < nks; ++k) v[j] += *(const f32x4*)(Pp + (size_t)k * NS * DM + 4 * lane + 256 * j);
        ss += (v[j][0] * v[j][0] + v[j][1] * v[j][1]) + (v[j][2] * v[j][2] + v[j][3] * v[j][3]); }
    ss = wave_sum(ss); const float rs = rsqrtf(ss * (1.f / DM) + EPS);
#pragma unroll
    for (int j = 0; j < 8; ++j) { *(f32x4*)(Xnext + 4 * lane + 256 * j) = v[j]; const f32x4 o = v[j] * rs * *(const f32x4*)(g + 4 * lane + 256 * j);
        u32x2 w; w.x = cvt_pk_bf16(o[0], o[1]); w.y = cvt_pk_bf16(o[2], o[3]); *(u32x2*)(Aout + 4 * lane + 256 * j) = w; }
}
__device__ __forceinline__ void phase_final(const Args& a, int G, bool prompt_done) {
    if (prompt_done) {
        extern __shared__ __attribute__((aligned(16))) unsigned char lds_dyn_[]; float* red8 = (float*)lds_dyn_;
        const int tid_ = threadIdx.x, lane_ = tid_ & 63, wave_ = tid_ >> 6;
        for (int rs_ = blockIdx.x; rs_ < NS; rs_ += G) {
            const float* src = (const float*)(a.ws + WS_X2S) + (size_t)rs_ * DM + wave_ * 256 + 4 * lane_; const float* pp = (const float*)(a.ws + WS_P8) + (size_t)rs_ * DM + wave_ * 256 + 4 * lane_;
            f32x4 v = *(const f32x4*)src; f32x4 p[22];
#pragma unroll
            for (int k = 0; k < 22; ++k) p[k] = *(const f32x4*)(pp + (size_t)k * NS * DM);
#pragma unroll
            for (int k = 0; k < 22; ++k) v += p[k];
            const float ss = wave_sum((v[0] * v[0] + v[1] * v[1]) + (v[2] * v[2] + v[3] * v[3]));
            __syncthreads();
            if (lane_ == 0) red8[wave_] = ss;
            __syncthreads();
            const float tot = ((red8[0] + red8[1]) + (red8[2] + red8[3])) + ((red8[4] + red8[5]) + (red8[6] + red8[7]));
            const float rs = rsqrtf(tot * (1.f / DM) + EPS);
            *(f32x4*)(a.out + O_YS + (size_t)rs_ * DM + wave_ * 256 + 4 * lane_) = v * rs * *(const f32x4*)(a.in[I_GFIN] + wave_ * 256 + 4 * lane_);
        }
        return;
    }
    const int lane = threadIdx.x & 63, wave = threadIdx.x >> 6; const int gw = blockIdx.x * 8 + wave, NGW = G * 8;
    for (int r = prompt_done ? NP + gw : gw; r < MV; r += NGW) { float* p = r < NP ? a.out + O_YP + (size_t)r * DM : a.out + O_YS + (size_t)(r - NP) * DM;
        const float* src = r < NP ? p : (const float*)(a.ws + WS_X2S) + (size_t)(r - NP) * DM;
        f32x4 v[8]; float ss = 0.f;
#pragma unroll
        for (int j = 0; j < 8; ++j) { v[j] = *(const f32x4*)(src + 4 * lane + 256 * j);
            if (r >= NP) { for (int k = 0; k < 22; ++k) v[j] += *(const f32x4*)((const float*)(a.ws + WS_P8) + ((size_t)k * NS + (r - NP)) * DM + 4 * lane + 256 * j); } ss += (v[j][0] * v[j][0] + v[j][1] * v[j][1]) + (v[j][2] * v[j][2] + v[j][3] * v[j][3]); }
        ss = wave_sum(ss); const float rs = rsqrtf(ss * (1.f / DM) + EPS);
#pragma unroll
        for (int j = 0; j < 8; ++j) *(f32x4*)(p + 4 * lane + 256 * j) = v[j] * rs * *(const f32x4*)(a.in[I_GFIN] + 4 * lane + 256 * j); }
}

#define XB_TMO      128
#define XB_XCNT(j)  (256  + 64 * (j))
#define XB_XSUB(j)  (1280 + 64 * (j))
#define XB_XGEN(j)  (2304 + 64 * (j))
#define XB_TOP      3328
#define XB_TOPGEN   3392
#define XCD_BAR_WORDS 3456
#define XB_SPIN_CAP (1u << 18)
__device__ __forceinline__ unsigned xb_ld(unsigned* p)              { return __hip_atomic_load(p, __ATOMIC_RELAXED, __HIP_MEMORY_SCOPE_AGENT); }
__device__ __forceinline__ unsigned xb_add(unsigned* p, unsigned v) { return __hip_atomic_fetch_add(p, v, __ATOMIC_RELAXED, __HIP_MEMORY_SCOPE_AGENT); }
__device__ __forceinline__ unsigned xb_xcc_id() { return (unsigned)__builtin_amdgcn_s_getreg((3 << 11) | 20) & 0xFu; }
#define XB_SPIN(cond, bar) do { unsigned _sp = 0; while (cond) { __builtin_amdgcn_s_sleep(1); \
    if ((++_sp & 255u) == 0u) { if (xb_ld(&(bar)[XB_TMO])) break; if (_sp > XB_SPIN_CAP) { atomicAdd(&(bar)[XB_TMO], 1u); break; } } } } while (0)
struct XcdBarrier { unsigned* bar; unsigned x; volatile LAS unsigned* st; };
__device__ __forceinline__ void xcd_barrier_complete(unsigned* bar, unsigned x, unsigned& nloc, unsigned& nx) {
    const unsigned G = gridDim.x * gridDim.y * gridDim.z;
    unsigned sum, cnt, mine, sp = 0u;
    for (;;) {
        sum = 0u; cnt = 0u; mine = 0u;
#pragma unroll
        for (unsigned j = 0; j < 16; ++j) { const unsigned c = xb_ld(&bar[XB_XCNT(j)]); sum += c; cnt += (c > 0u) ? 1u : 0u; mine = (j == x) ? c : mine; }
        if (sum == G) break;
        __builtin_amdgcn_s_sleep(1);
        if ((++sp & 255u) == 0u) { if (xb_ld(&bar[XB_TMO])) break; if (sp > XB_SPIN_CAP) { atomicAdd(&bar[XB_TMO], 1u); break; } }
    }
    nloc = mine > 0u ? mine : 1u; nx = cnt > 0u ? cnt : 1u;
}
__device__ __forceinline__ void xcd_barrier(const XcdBarrier& b) {
    asm volatile("s_waitcnt vmcnt(0)" ::: "memory");
    __syncthreads();
    if (threadIdx.x == 0) {
        unsigned* bar = b.bar;
        __builtin_amdgcn_s_waitcnt(0);
        unsigned nloc = b.st[0], nx = b.st[1];
        if (nloc == 0u) { xcd_barrier_complete(bar, b.x, nloc, nx); b.st[0] = nloc; b.st[1] = nx; }
        const unsigned old = xb_add(&bar[XB_XSUB(b.x)], 1u);
        const unsigned gen = old / nloc;
        if (old + 1u == (gen + 1u) * nloc) {
            __builtin_amdgcn_fence(__ATOMIC_RELEASE, "agent");
            asm volatile("s_waitcnt vmcnt(0)" ::: "memory");
            const unsigned og = xb_add(&bar[XB_TOP], 1u);
            const unsigned tg = og / nx;
            if (og + 1u == (tg + 1u) * nx) xb_add(&bar[XB_TOPGEN], 1u);
            else XB_SPIN(xb_ld(&bar[XB_TOPGEN]) == tg, bar);
            __builtin_amdgcn_fence(__ATOMIC_ACQUIRE, "agent");
            xb_add(&bar[XB_XGEN(b.x)], 1u);
            asm volatile("s_waitcnt vmcnt(0)" ::: "memory");
        } else {
            XB_SPIN(xb_ld(&bar[XB_XGEN(b.x)]) == gen, bar);
            __builtin_amdgcn_fence(__ATOMIC_ACQUIRE, "agent");
            asm volatile("s_waitcnt vmcnt(0)" ::: "memory");
        }
    }
    __syncthreads();
}

__global__ void __launch_bounds__(512, 2) mk_fwd(Args a) {
    extern __shared__ __attribute__((aligned(16))) unsigned char lds[];
    cg::grid_group grid = cg::this_grid();
    LAS unsigned char* ring = (LAS unsigned char*)lds;
    const int G = gridDim.x, bx = blockIdx.x;
    unsigned char* ws = a.ws;
    const int lo = a.ph_lo, hi = a.ph_hi;
#define IN(k) (lo <= (k) && (k) < hi)
    XcdBarrier xbar; xbar.bar = (unsigned*)ws; xbar.x = xb_xcc_id(); xbar.st = (volatile LAS unsigned*)(ring + (LDS_BYTES - 64));
    if (threadIdx.x == 0) { xbar.st[0] = 0u; xbar.st[1] = 0u; if (hi - lo > 1) (void)xb_add(&xbar.bar[XB_XCNT(xbar.x)], 1u); }
    __syncthreads();
    if (hi > 4096) grid.sync();
#define SEAM(k) do { if (IN(k) && IN((k) + 1)) xcd_barrier(xbar); } while (0)
    const bf16_t* ABUF = (const bf16_t*)(ws + WS_ABUF);

    if (IN(0)) { phase_prologue(a, lds, G); }
    SEAM(0);
    if (IN(1)) {
        { pg8::SchedStd S; S.init(ws + WS_MN, ws + WS_WKV, DM, DM, 1024, 4096, G, bx);
          pg8::EpiKV E{a.out + O_PMK, a.out + O_PMV, (bf16_t*)(ws + WS_KB), (bf16_t*)(ws + WS_VT)};
          pg8::gemm_phase<pg8::EpiKV, pg8::SchedStd, true>(ring, DM, DM, DM, S, E); }
        { const int nwg1 = 4 * 16; pg8::SchedStd S; S.init(ABUF, ws + WS_WIN, DM, DM, MA, ZW, G, (bx + G - (nwg1 % G)) % G); pg8::EpiBf16 E{(bf16_t*)(ws + WS_Z), ZW};
          pg8::gemm_phase<pg8::EpiBf16, pg8::SchedStd, true>(ring, DM, DM, DM, S, E); }
        if (G == 256 && bx >= 212) { __syncthreads(); late_transposes(a, lds, 0, 32 * 88, (bx - 212) * 8 + (threadIdx.x >> 6), 352); }
    }
    SEAM(1);
    if (IN(2)) {
        for (int it = bx; it < 128; it += G) rg_item(a, lds, it >> 5, it & 7, (it >> 3) & 3);
        __syncthreads();
        for (int j = (bx + G - (128 % G)) % G; j < 128; j += G) ml_item(a, lds, j >> 5, (j >> 3) & 3, (j >> 1) & 3, j & 1);
        __syncthreads();
        for (int j = bx; j < NS; j += G) sample_item(a, lds, j);
        __syncthreads();
        if (G == 256) late_transposes(a, lds, 3 * 32 * 88, LATE_ITEMS, bx * 8 + (threadIdx.x >> 6), 2048);
        else late_transposes(a, lds, 0, LATE_ITEMS, bx * 8 + (threadIdx.x >> 6), G * 8);
    }
    SEAM(2);
    if (IN(3)) { phase_finalize(a, lds, G); }
    SEAM(3);
    if (IN(4)) {
        { pg8::SchedStd S; S.init(ws + WS_YMIX, ws + WS_WOUT, DM, DM, NP, DM, G, bx);
          pg8::EpiRes<1> E{a.in[I_XP], a.in[I_XS], (float*)(ws + WS_X1), nullptr, nullptr, a.in[I_GXA], (bf16_t*)(ws + WS_ABUF), (float*)(ws + WS_SSQ1)};
          pg8::gemm_phase<pg8::EpiRes<1>, pg8::SchedStd, true>(ring, DM, DM, DM, S, E); }
        { pg8::SchedSK S{(const char*)(ws + WS_YMIX) + (size_t)NP * DM * 2, (const char*)(ws + WS_WOUT), DM, 8, 8, G, bx}; pg8::EpiPartial E{(float*)(ws + WS_P3), DM};
          pg8::gemm_phase<pg8::EpiPartial, pg8::SchedSK, true>(ring, DM, DM, 256, S, E); }
    }
    SEAM(4);
    if (IN(5)) {
        { const int gw = bx * 8 + (threadIdx.x >> 6); if (gw < NS) sample_prep(a.in[I_XS] + (size_t)gw * DM, (const float*)(ws + WS_P3) + (size_t)gw * DM, 8, a.in[I_GXA], (bf16_t*)(ws + WS_ABUF) + (size_t)(NP + gw) * DM, (float*)(ws + WS_X1S) + (size_t)gw * DM, threadIdx.x & 63); }
        pg8::SchedStd S; S.init(ABUF, ws + WS_WQ, DM, DM, NP, DM, G, bx);
        pg8::EpiQ E{(const float*)(ws + WS_SSQ1), (bf16_t*)(ws + WS_QB), 0.04419417382415922f};
        pg8::gemm_phase<pg8::EpiQ, pg8::SchedStd, true>(ring, DM, DM, DM, S, E);
    }
    SEAM(5);
    if (IN(6)) {
        if (G >= 128) { pg8::SchedS S{(const char*)(ws + WS_QB), (const char*)(ws + WS_KB), G, bx}; pg8::EpiSoftmax E{(bf16_t*)(ws + WS_P)};
            pg8::gemm_phase<pg8::EpiSoftmax, pg8::SchedS, false>(ring, DM, DM, 512, S, E); }
        __syncthreads();
        { pg8::SchedSK S{(const char*)(ws + WS_ABUF) + (size_t)NP * DM * 2, (const char*)(ws + WS_WQ), DM, 8, 8, G, (bx + G - (128 % G)) % G}; pg8::EpiPartial E{(float*)(ws + WS_P4), DM};
          pg8::gemm_phase<pg8::EpiPartial, pg8::SchedSK, true>(ring, DM, DM, 256, S, E); }
        if (G == 256 && bx >= 192) { __syncthreads(); late_transposes(a, lds, 32 * 88, 2 * 32 * 88, (bx - 192) * 8 + (threadIdx.x >> 6), 512); }
    }
    SEAM(6);
    if (IN(7)) {
        { pg8::SchedPV S{(const char*)(ws + WS_P), (const char*)(ws + WS_VT), G, bx}; pg8::EpiBf16 E{(bf16_t*)(ws + WS_OB), DM};
          pg8::gemm_phase<pg8::EpiBf16, pg8::SchedPV, true>(ring, 256, 256, 256, S, E); }
        __syncthreads();
        for (int it = bx; it < NS * 4; it += G) sattn_item(a, lds, it >> 2, it & 3);
    }
    SEAM(7);
    if (IN(8)) {
        { pg8::SchedStd S; S.init(ws + WS_OB, ws + WS_WO, DM, DM, NP, DM, G, bx);
          pg8::EpiRes<2> E{nullptr, nullptr, (float*)(ws + WS_X1), nullptr, nullptr, a.in[I_GFFN], (bf16_t*)(ws + WS_ABUF), (float*)(ws + WS_SSQ2)};
          pg8::gemm_phase<pg8::EpiRes<2>, pg8::SchedStd, true>(ring, DM, DM, DM, S, E); }
        { pg8::SchedSK S{(const char*)(ws + WS_OB) + (size_t)NP * DM * 2, (const char*)(ws + WS_WO), DM, 8, 8, G, bx}; pg8::EpiPartial E{(float*)(ws + WS_P6), DM};
          pg8::gemm_phase<pg8::EpiPartial, pg8::SchedSK, true>(ring, DM, DM, 256, S, E); }
    }
    SEAM(8);
    if (IN(9)) {
        const int gw = bx * 8 + (threadIdx.x >> 6); if (gw < NS) sample_prep((const float*)(ws + WS_X1S) + (size_t)gw * DM, (const float*)(ws + WS_P6) + (size_t)gw * DM, 8, a.in[I_GFFN], (bf16_t*)(ws + WS_ABUF) + (size_t)(NP + gw) * DM, (float*)(ws + WS_X2S) + (size_t)gw * DM, threadIdx.x & 63);
    }
    SEAM(9);
    if (IN(10)) {
        { pg8::SchedStd S; S.init(ABUF, ws + WS_WGU, DM, DM, NP, 2 * DFF, G, bx);
          pg8::EpiGU E{(const float*)(ws + WS_SSQ2), (bf16_t*)(ws + WS_H)};
          pg8::gemm_phase<pg8::EpiGU, pg8::SchedStd, true>(ring, DM, DM, DM, S, E); }
        { const int nwg1 = (NP / 256) * (2 * DFF / 256); pg8::SchedStd S; S.init(ABUF + (size_t)NP * DM, ws + WS_WGU, DM, DM, 256, 2 * DFF, G, (bx + G - (nwg1 % G)) % G);
          pg8::EpiGU E{nullptr, (bf16_t*)(ws + WS_H) + (size_t)NP * DFF};
          pg8::gemm_phase<pg8::EpiGU, pg8::SchedStd, true>(ring, DM, DM, DM, S, E); }
        if (G == 256 && bx >= 172) { __syncthreads(); late_transposes(a, lds, 2 * 32 * 88, 3 * 32 * 88, (bx - 172) * 8 + (threadIdx.x >> 6), 672); }
    }
    SEAM(10);
    if (IN(11)) {
        if (G == 256) { pg8::SchedStd S; S.init(ws + WS_H, ws + WS_WD, DFF, DFF, NP, DM, G, bx);
          pg8::EpiFinal E{(const float*)(ws + WS_X1), a.out + O_YP, a.in[I_GFIN], (float*)(ws + WS_SLOTS), (unsigned*)ws + 4096};
          pg8::gemm_phase<pg8::EpiFinal, pg8::SchedStd, false>(ring, DFF, DFF, DFF, S, E); }
        else { pg8::SchedStd S; S.init(ws + WS_H, ws + WS_WD, DFF, DFF, NP, DM, G, bx);
          pg8::EpiRes<3> E{nullptr, nullptr, (float*)(ws + WS_X1), a.out + O_YP, a.out + O_YS, nullptr, nullptr, nullptr};
          pg8::gemm_phase<pg8::EpiRes<3>, pg8::SchedStd, true>(ring, DFF, DFF, DFF, S, E); }
        { pg8::SchedSK S{(const char*)(ws + WS_H) + (size_t)NP * DFF * 2, (const char*)(ws + WS_WD), DFF, 8, 22, G, bx}; pg8::EpiPartial E{(float*)(ws + WS_P8), DM};
          pg8::gemm_phase<pg8::EpiPartial, pg8::SchedSK, true>(ring, DFF, DFF, 256, S, E); }
    }
    SEAM(11);
    if (IN(12)) { phase_final(a, G, G == 256); }
#undef IN
#undef SEAM
}

extern "C" void kernel_launch(void* const* d_in, const int* in_sizes, int n_in, void* d_out, int out_size, void* d_ws, size_t ws_size, hipStream_t stream) {
    static int grid = 0;
    if (grid == 0) {
        if (n_in != 35 || (size_t)out_size != O_END || ws_size < WS_END) { fprintf(stderr, "kernel_launch: unexpected sizes n_in %d out %d ws %zu\n", n_in, out_size, ws_size); grid = -1; return; }
        int dev = 0, cus = 0, per_cu = 0;
        (void)hipGetDevice(&dev); (void)hipDeviceGetAttribute(&cus, hipDeviceAttributeMultiprocessorCount, dev);
        if (hipFuncSetAttribute((const void*)mk_fwd, hipFuncAttributeMaxDynamicSharedMemorySize, LDS_BYTES) != hipSuccess) { fprintf(stderr, "kernel_launch: hipFuncSetAttribute failed\n"); grid = -1; return; }
        if (hipOccupancyMaxActiveBlocksPerMultiprocessor(&per_cu, (const void*)mk_fwd, 512, LDS_BYTES) != hipSuccess || per_cu < 1) { fprintf(stderr, "kernel_launch: occupancy query says %d\n", per_cu); per_cu = 1; }
        (void)hipGetLastError();
        grid = cus * 1;
        if (grid < 128) fprintf(stderr, "kernel_launch: grid %d < 128\n", grid);
    }
    if (grid < 0) return;
    Args a{};
    for (int i = 0; i < 35; ++i) a.in[i] = (const float*)d_in[i];
    a.out = (float*)d_out; a.ws = (unsigned char*)d_ws;
    constexpr int NL = MK_N_LAUNCHES;
    if (hipMemsetAsync(d_ws, 0, 32768, stream) != hipSuccess) { fprintf(stderr, "kernel_launch: memset of the barrier word failed\n"); return; }
    for (int li = 0; li < NL; ++li) {
        a.ph_lo = (NL == 1) ? 0 : li; a.ph_hi = (NL == 1) ? N_PHASES : li + 1;
        void* args[] = {&a};
        hipError_t e = hipLaunchCooperativeKernel((const void*)mk_fwd, dim3(grid), dim3(512), args, LDS_BYTES, stream);
        if (e != hipSuccess) { fprintf(stderr, "kernel_launch: cooperative launch %d failed: %s (grid %d)\n", li, hipGetErrorString(e), grid); break; }
    }
}
```

```cpp
#include <hip/hip_runtime.h>
#include <hip/hip_cooperative_groups.h>
#include <cstdio>
#include <cstdint>
namespace cg = cooperative_groups;

#ifndef MK_N_LAUNCHES
#define MK_N_LAUNCHES 1
#endif

#define LAS __attribute__((address_space(3)))
typedef unsigned short bf16_t;
typedef short bf16x8 __attribute__((ext_vector_type(8)));
typedef float f32x4 __attribute__((ext_vector_type(4)));
typedef unsigned u32x4 __attribute__((ext_vector_type(4)));
typedef unsigned u32x2 __attribute__((ext_vector_type(2)));

constexpr int DM = 2048, NP = 8192, NS = 128, MV = NP + NS, MA = 8448, ZW = 5120, INW = 5128, DFF = 5632, SEQ = 2048, NMEM = 256;
constexpr float EPS = 1e-6f;
constexpr int N_PHASES = 13;

constexpr size_t O_YP = 0, O_YS = O_YP + (size_t)NP * DM, O_PRGH = O_YS + (size_t)NS * DM, O_PRGC = O_PRGH + 4096, O_PMLC = O_PRGC + 12288,
                 O_PMLN = O_PMLC + 524288, O_PMLM = O_PMLN + 2048, O_PMK = O_PMLM + 16, O_PMV = O_PMK + 2097152, O_SRGH = O_PMV + 2097152,
                 O_SRGC = O_SRGH + 131072, O_SMLC = O_SRGC + 393216, O_SMLN = O_SMLC + 16777216, O_SMLM = O_SMLN + 65536, O_END = O_SMLM + 512;

constexpr size_t MiB = 1u << 20;
constexpr size_t WS_WIN = 1 * MiB, WS_WOUT = 21 * MiB, WS_WQ = 29 * MiB, WS_WKV = 37 * MiB, WS_WO = 53 * MiB, WS_WGU = 61 * MiB, WS_WD = 105 * MiB,
                 WS_WRG = 127 * MiB, WS_ABUF = 128 * MiB, WS_MN = 161 * MiB, WS_Z = 165 * MiB, WS_GATES = 248 * MiB, WS_YPRE = 249 * MiB,
                 WS_HPRE = 282 * MiB, WS_YMIX = 315 * MiB, WS_X1 = 348 * MiB, WS_SSQ1 = 414 * MiB, WS_SSQ2 = 416 * MiB, WS_QB = 418 * MiB,
                 WS_OB = 451 * MiB, WS_KB = 484 * MiB, WS_VT = 488 * MiB, WS_P = 492 * MiB, WS_H = 508 * MiB, WS_X1S = 600 * MiB, WS_X2S = 601 * MiB, WS_P3 = 604 * MiB, WS_P4 = 612 * MiB, WS_P6 = 620 * MiB, WS_P8 = 628 * MiB, WS_CPRE = 652 * MiB, WS_RGE = 685 * MiB, WS_MLS = 686 * MiB, WS_CIN = 687 * MiB, WS_CINF = 689 * MiB, WS_GL = 692 * MiB, WS_SLOTS = 693 * MiB, WS_END = 694 * MiB;

constexpr int LDS_BYTES = 147456;

__device__ __forceinline__ unsigned cvt_pk_bf16(float lo, float hi) { unsigned r; asm volatile("v_cvt_pk_bf16_f32 %0, %1, %2" : "=v"(r) : "v"(lo), "v"(hi)); return r; }
__device__ __forceinline__ float bf2f(unsigned short b) { return __uint_as_float((unsigned)b << 16); }
__device__ __forceinline__ bf16_t f2bf(float f) { return (bf16_t)(cvt_pk_bf16(f, 0.f) & 0xffffu); }
__device__ __forceinline__ float bflo(unsigned w) { return __uint_as_float(w << 16); }
__device__ __forceinline__ float bfhi(unsigned w) { return __uint_as_float(w & 0xffff0000u); }
__device__ __forceinline__ float wave_sum(float v) {
#pragma unroll
    for (int o = 1; o < 64; o <<= 1) v += __shfl_xor(v, o);
    return v;
}
__device__ __forceinline__ float wave_max(float v) {
#pragma unroll
    for (int o = 1; o < 64; o <<= 1) v = fmaxf(v, __shfl_xor(v, o));
    return v;
}
__device__ __forceinline__ float sigmoidf_(float x) { return __builtin_amdgcn_rcpf(1.f + __expf(-x)); }
__device__ __forceinline__ float gelu_tanh(float x) { const float u2 = 1.5957691216057308f * (x + 0.044715f * x * x * x); return x * sigmoidf_(u2); }
#define LDS_WAIT() asm volatile("s_waitcnt lgkmcnt(0)" ::: "memory")
#define LBAR() do { asm volatile("s_waitcnt lgkmcnt(0)" ::: "memory"); __builtin_amdgcn_s_barrier(); asm volatile("" ::: "memory"); } while (0)

namespace pg8 {
constexpr int BM = 256, BK = 64, HALF = 128, HTB = HALF * BK * 2, STAGE_BYTES = 8 * HTB, NXCD = 8, WGM = 8;
__host__ __device__ __forceinline__ int lds_byte(int r, int c) { const int st = (r >> 4) * 2 + (c >> 5), rr = r & 15, cc = c & 31, ob = rr * 64 + cc * 2; return st * 1024 + (ob ^ (((ob >> 9) & 1) << 5)); }
__host__ __device__ __forceinline__ void stage_rc(int b, int& R, int& C) { const int st = b / 1024, sb = b % 1024, swz = sb ^ (((sb >> 9) & 1) << 5); R = (st >> 1) * 16 + swz / 64; C = (st & 1) * 32 + (swz % 64) / 2; }
__host__ __device__ __forceinline__ int perm32(int rho) { const int n = rho >> 4, i = rho & 15; return 8 * (i >> 2) + 4 * n + (i & 3); }

struct Unit { int pm, pn; };

struct SchedStd {
    const char* A; const char* B; size_t sA, sB; int nM, nN, nwg, G, c;
    __device__ void init(const void* A_, const void* B_, int lda, int ldb, int M, int N, int G_, int c_) {
        A = (const char*)A_; B = (const char*)B_; sA = (size_t)BM * lda * 2; sB = (size_t)BM * ldb * 2; nM = M / BM; nN = N / BM; nwg = nM * nN; G = G_; c = c_; }
    __device__ bool next(int i, Unit& u) const {
        const long L = (long)i * G + c; if (L >= nwg) return false;
        int wgid = (int)L; { const int q = nwg / NXCD, r = nwg % NXCD, xcd = wgid % NXCD, off = wgid / NXCD; wgid = (xcd < r ? xcd * (q + 1) : r * (q + 1) + (xcd - r) * q) + off; }
        const int nig = WGM * nN, gid = wgid / nig, fm = gid * WGM, gsz = (nM - fm) < WGM ? (nM - fm) : WGM;
        u.pm = fm + ((wgid % nig) % gsz); u.pn = (wgid % nig) / gsz; return true;
    }
    __device__ __forceinline__ const char* aptr(const Unit& u) const { return A + (size_t)u.pm * sA; }
    __device__ __forceinline__ const char* bptr(const Unit& u) const { return B + (size_t)u.pn * sB; }
};
struct SchedS {
    const char* Q; const char* Kb; int G, c;
    __device__ bool next(int i, Unit& u) const { const int L = i * G + c; if (L >= 128) return false; const int b = L >> 5, h = (L >> 3) & 3, qt = L & 7; u.pm = b * 8 + qt; u.pn = h; return true; }
    __device__ __forceinline__ const char* aptr(const Unit& u) const { return Q + ((size_t)u.pm * 256 * DM + (size_t)u.pn * 512) * 2; }
    __device__ __forceinline__ const char* bptr(const Unit& u) const { return Kb + ((size_t)(u.pm >> 3) * 256 * DM + (size_t)u.pn * 512) * 2; }
};
struct SchedPV {
    const char* P; const char* VT; int G, c;
    __device__ bool next(int i, Unit& u) const { const int L = i * G + c; if (L >= 256) return false; const int bh = L >> 4, qt = (L >> 1) & 7, nh = L & 1; u.pm = (bh >> 2) * 8 + qt; u.pn = (bh & 3) * 2 + nh; return true; }
    __device__ __forceinline__ const char* aptr(const Unit& u) const { const int bh = (u.pm >> 3) * 4 + (u.pn >> 1); return P + ((size_t)bh * 2048 + (size_t)(u.pm & 7) * 256) * 256 * 2; }
    __device__ __forceinline__ const char* bptr(const Unit& u) const { const int bh = (u.pm >> 3) * 4 + (u.pn >> 1); return VT + ((size_t)bh * 512 + (size_t)(u.pn & 1) * 256) * 256 * 2; }
};

typedef f32x4 Acc[2][2][4][2];
__device__ __forceinline__ u32x4 pack8(const f32x4 v0, const f32x4 v1) { u32x4 w; w.x = cvt_pk_bf16(v0[0], v0[1]); w.y = cvt_pk_bf16(v0[2], v0[3]); w.z = cvt_pk_bf16(v1[0], v1[1]); w.w = cvt_pk_bf16(v1[2], v1[3]); return w; }

struct EpiBf16 {
    static constexpr bool PERM = true, AFTER_DRAIN = false;
    bf16_t* O; int ldc;
    __device__ __forceinline__ void operator()(const Acc& acc, const Unit& u, int wr, int wc, int fr, int fq) const {
        const int row0 = u.pm * BM + wr * 64 + fr, col0 = u.pn * BM + wc * 32 + 8 * fq;
#pragma unroll
        for (int ai = 0; ai < 2; ++ai)
#pragma unroll
            for (int m = 0; m < 4; ++m) { bf16_t* rowp = O + (size_t)(row0 + ai * HALF + m * 16) * ldc + col0;
#pragma unroll
                for (int bj = 0; bj < 2; ++bj) *(u32x4*)(rowp + bj * HALF) = pack8(acc[ai][bj][m][0], acc[ai][bj][m][1]); }
    }
};
struct EpiKV {
    static constexpr bool PERM = true, AFTER_DRAIN = false;
    float* outK; float* outV; bf16_t* KB; bf16_t* VT;
    __device__ __forceinline__ void operator()(const Acc& acc, const Unit& u, int wr, int wc, int fr, int fq) const {
        const int row0 = u.pm * BM + wr * 64 + fr, col0 = (u.pn & 7) * BM + wc * 32 + 8 * fq; const bool isV = u.pn >= 8;
#pragma unroll
        for (int ai = 0; ai < 2; ++ai)
#pragma unroll
            for (int m = 0; m < 4; ++m) { const int r = row0 + ai * HALF + m * 16;
#pragma unroll
                for (int bj = 0; bj < 2; ++bj) { const int c = col0 + bj * HALF; const f32x4 v0 = acc[ai][bj][m][0], v1 = acc[ai][bj][m][1];
                    float* o = (isV ? outV : outK) + (size_t)r * DM + c; *(f32x4*)o = v0; *(f32x4*)(o + 4) = v1;
                    if (!isV) *(u32x4*)(KB + (size_t)r * DM + c) = pack8(v0, v1);
                    else { const int b = r >> 8, mm = r & 255, h = c >> 9, d = c & 511; bf16_t* base = VT + ((size_t)((b * 4 + h) * 512 + d)) * 256 + mm;
#pragma unroll
                        for (int e = 0; e < 4; ++e) { base[(size_t)e * 256] = f2bf(v0[e]); base[(size_t)(4 + e) * 256] = f2bf(v1[e]); } } } }
    }
};
template <int MODE> struct EpiRes {
    static constexpr bool PERM = true, AFTER_DRAIN = false;
    const float* xp; const float* xs; float* X1; float* yp; float* ys; const float* g; bf16_t* Aout; float* SSQ;
    __device__ __forceinline__ void operator()(const Acc& acc, const Unit& u, int wr, int wc, int fr, int fq) const {
        const int row0 = u.pm * BM + wr * 64 + fr, col0 = u.pn * BM + wc * 32 + 8 * fq;
        f32x4 gv[2][2];
        if (MODE != 3) {
#pragma unroll
            for (int bj = 0; bj < 2; ++bj)
#pragma unroll
                for (int n = 0; n < 2; ++n) gv[bj][n] = *(const f32x4*)(g + col0 + bj * HALF + 4 * n); }
#pragma unroll
        for (int ai = 0; ai < 2; ++ai)
#pragma unroll
            for (int m = 0; m < 4; ++m) { const int r = row0 + ai * HALF + m * 16;
                const float* src; float* dst;
                if (MODE == 1) { const int rc = r < MV ? r : MV - 1; src = rc < NP ? xp + (size_t)rc * DM : xs + (size_t)(rc - NP) * DM; dst = X1 + (size_t)r * DM; }
                else if (MODE == 2) { src = X1 + (size_t)r * DM; dst = X1 + (size_t)r * DM; }
                else { src = X1 + (size_t)r * DM; dst = r < NP ? yp + (size_t)r * DM : (r < MV ? ys + (size_t)(r - NP) * DM : X1 + (size_t)r * DM); }
                float ss = 0.f;
#pragma unroll
                for (int bj = 0; bj < 2; ++bj) { const int c = col0 + bj * HALF;
                    const f32x4 v0 = *(const f32x4*)(src + c) + acc[ai][bj][m][0], v1 = *(const f32x4*)(src + c + 4) + acc[ai][bj][m][1];
                    *(f32x4*)(dst + c) = v0; *(f32x4*)(dst + c + 4) = v1;
                    if (MODE != 3) { ss += (v0[0] * v0[0] + v0[1] * v0[1]) + (v0[2] * v0[2] + v0[3] * v0[3]) + (v1[0] * v1[0] + v1[1] * v1[1]) + (v1[2] * v1[2] + v1[3] * v1[3]);
                        *(u32x4*)(Aout + (size_t)r * DM + c) = pack8(v0 * gv[bj][0], v1 * gv[bj][1]); } }
                if (MODE != 3) { ss += __shfl_xor(ss, 16); ss += __shfl_xor(ss, 32); if (fq == 0) SSQ[(size_t)r * 32 + u.pn * 4 + wc] = ss; }
                if (m & 1) asm volatile("" ::: "memory"); }
    }
};
__device__ __forceinline__ float row_rstd(const float* SSQ, int r, int fq) {
    const float* p = SSQ + (size_t)r * 32 + fq * 8; const f32x4 t0 = *(const f32x4*)p, t1 = *(const f32x4*)(p + 4);
    float s = (t0[0] + t0[1]) + (t0[2] + t0[3]) + (t1[0] + t1[1]) + (t1[2] + t1[3]); s += __shfl_xor(s, 16); s += __shfl_xor(s, 32);
    return rsqrtf(s * (1.f / DM) + EPS);
}
struct EpiQ {
    static constexpr bool PERM = true, AFTER_DRAIN = false;
    const float* SSQ; bf16_t* O; float scale;
    __device__ __forceinline__ void operator()(const Acc& acc, const Unit& u, int wr, int wc, int fr, int fq) const {
        const int row0 = u.pm * BM + wr * 64 + fr, col0 = u.pn * BM + wc * 32 + 8 * fq;
#pragma unroll
        for (int ai = 0; ai < 2; ++ai)
#pragma unroll
            for (int m = 0; m < 4; ++m) { const int r = row0 + ai * HALF + m * 16; const float rs = row_rstd(SSQ, r, fq) * scale; bf16_t* rowp = O + (size_t)r * DM + col0;
#pragma unroll
                for (int bj = 0; bj < 2; ++bj) *(u32x4*)(rowp + bj * HALF) = pack8(acc[ai][bj][m][0] * rs, acc[ai][bj][m][1] * rs); }
    }
};
struct EpiGU {
    static constexpr bool PERM = true, AFTER_DRAIN = false;
    const float* SSQ; bf16_t* H;
    __device__ __forceinline__ void operator()(const Acc& acc, const Unit& u, int wr, int wc, int fr, int fq) const {
        const int row0 = u.pm * BM + wr * 64 + fr, col0 = u.pn * HALF + wc * 32 + 8 * fq;
#pragma unroll
        for (int ai = 0; ai < 2; ++ai)
#pragma unroll
            for (int m = 0; m < 4; ++m) { const int r = row0 + ai * HALF + m * 16; const float rs = SSQ ? row_rstd(SSQ, r, fq) : 1.f; f32x4 hv[2];
#pragma unroll
                for (int n = 0; n < 2; ++n)
#pragma unroll
                    for (int j = 0; j < 4; ++j) { const float gg = acc[ai][0][m][n][j] * rs, uu = acc[ai][1][m][n][j] * rs; hv[n][j] = gg * sigmoidf_(gg) * uu; }
                *(u32x4*)(H + (size_t)r * DFF + col0) = pack8(hv[0], hv[1]); }
    }
};
struct EpiSoftmax {
    static constexpr bool PERM = true, AFTER_DRAIN = true;
    bf16_t* P;
    __device__ __forceinline__ void operator()(const Acc&, const Unit&, int, int, int, int) const {}
    __device__ __forceinline__ void fused(Acc& acc, const Unit& u, int wr, int wc, int fr, int fq, LAS unsigned char* lds, int wid, int lane) const {
        LAS float* PM = (LAS float*)lds; LAS float* PS = (LAS float*)(lds + 4096);
#pragma unroll
        for (int ai = 0; ai < 2; ++ai)
#pragma unroll
            for (int m = 0; m < 4; ++m) { float mx = -3.0e38f;
#pragma unroll
                for (int bj = 0; bj < 2; ++bj)
#pragma unroll
                    for (int n = 0; n < 2; ++n) { const f32x4 x = acc[ai][bj][m][n]; mx = fmaxf(mx, fmaxf(fmaxf(x[0], x[1]), fmaxf(x[2], x[3]))); }
                mx = fmaxf(mx, __shfl_xor(mx, 16)); mx = fmaxf(mx, __shfl_xor(mx, 32));
                if (fq == 0) PM[(ai * HALF + wr * 64 + m * 16 + fr) * 4 + wc] = mx; }
        LDS_WAIT(); __builtin_amdgcn_s_barrier(); asm volatile("" ::: "memory");
#pragma unroll
        for (int ai = 0; ai < 2; ++ai)
#pragma unroll
            for (int m = 0; m < 4; ++m) { const int rl = ai * HALF + wr * 64 + m * 16 + fr; const f32x4 pm = *(const LAS f32x4*)(PM + rl * 4);
                const float M = fmaxf(fmaxf(pm[0], pm[1]), fmaxf(pm[2], pm[3])); float s = 0.f;
#pragma unroll
                for (int bj = 0; bj < 2; ++bj)
#pragma unroll
                    for (int n = 0; n < 2; ++n)
#pragma unroll
                        for (int j = 0; j < 4; ++j) { const float e = __expf(acc[ai][bj][m][n][j] - M); acc[ai][bj][m][n][j] = e; s += e; }
                s += __shfl_xor(s, 16); s += __shfl_xor(s, 32);
                if (fq == 0) PS[rl * 4 + wc] = s; }
        LDS_WAIT(); __builtin_amdgcn_s_barrier(); asm volatile("" ::: "memory");
        const int b = u.pm >> 3, qt = u.pm & 7, h = u.pn;
#pragma unroll
        for (int ai = 0; ai < 2; ++ai)
#pragma unroll
            for (int m = 0; m < 4; ++m) { const int rl = ai * HALF + wr * 64 + m * 16 + fr; const f32x4 ps = *(const LAS f32x4*)(PS + rl * 4);
                const float inv = __builtin_amdgcn_rcpf((ps[0] + ps[1]) + (ps[2] + ps[3]));
                bf16_t* rowp = P + ((size_t)((b * 4 + h) * 2048 + qt * 256 + rl)) * 256 + wc * 32 + 8 * fq;
#pragma unroll
                for (int bj = 0; bj < 2; ++bj) *(u32x4*)(rowp + bj * HALF) = pack8(acc[ai][bj][m][0] * inv, acc[ai][bj][m][1] * inv); }
        LDS_WAIT(); __builtin_amdgcn_s_barrier(); asm volatile("" ::: "memory");
    }
};

struct SchedSK {
    const char* A; const char* B; int ldb, npn, nks, G, c;
    __device__ bool next(int i, Unit& u) const { const int L = i * G + c; if (L >= npn * nks) return false; u.pn = L % npn; u.pm = L / npn; return true; }
    __device__ __forceinline__ const char* aptr(const Unit& u) const { return A + (size_t)u.pm * 512; }
    __device__ __forceinline__ const char* bptr(const Unit& u) const { return B + ((size_t)u.pn * 256 * ldb + (size_t)u.pm * 256) * 2; }
};
struct EpiPartial {
    static constexpr bool PERM = true, AFTER_DRAIN = false;
    float* D; int ld;
    __device__ __forceinline__ void operator()(const Acc& acc, const Unit& u, int wr, int wc, int fr, int fq) const {
        const int col0 = u.pn * BM + wc * 32 + 8 * fq;
#pragma unroll
        for (int m = 0; m < 4; ++m) { float* rowp = D + ((size_t)u.pm * 128 + wr * 64 + m * 16 + fr) * ld + col0;
#pragma unroll
            for (int bj = 0; bj < 2; ++bj) { *(f32x4*)(rowp + bj * HALF) = acc[0][bj][m][0]; *(f32x4*)(rowp + bj * HALF + 4) = acc[0][bj][m][1]; } }
    }
};

struct EpiFinal {
    static constexpr bool PERM = true, AFTER_DRAIN = true;
    const float* X1; float* yp; const float* g; float* slots; unsigned* cnt;
    __device__ __forceinline__ void operator()(const Acc&, const Unit&, int, int, int, int) const {}
    __device__ __forceinline__ void fused(Acc& acc, const Unit& u, int wr, int wc, int fr, int fq, LAS unsigned char* lds, int wid, int lane) const {
        LAS float* P = (LAS float*)lds;
        LAS float* S = (LAS float*)(lds + 4096);
        const int col0 = u.pn * BM + wc * 32 + 8 * fq;
#pragma unroll
        for (int ai = 0; ai < 2; ++ai)
#pragma unroll
            for (int m = 0; m < 4; ++m) { const int rl = ai * HALF + wr * 64 + m * 16 + fr; const float* src = X1 + (size_t)(u.pm * BM + rl) * DM + col0; float ss = 0.f;
#pragma unroll
                for (int bj = 0; bj < 2; ++bj) { acc[ai][bj][m][0] += *(const f32x4*)(src + bj * HALF); acc[ai][bj][m][1] += *(const f32x4*)(src + bj * HALF + 4);
                    const f32x4 v0 = acc[ai][bj][m][0], v1 = acc[ai][bj][m][1];
                    ss += (v0[0] * v0[0] + v0[1] * v0[1]) + (v0[2] * v0[2] + v0[3] * v0[3]) + (v1[0] * v1[0] + v1[1] * v1[1]) + (v1[2] * v1[2] + v1[3] * v1[3]); }
                ss += __shfl_xor(ss, 16); ss += __shfl_xor(ss, 32);
                if (fq == 0) P[rl * 4 + wc] = ss;
                if (m & 1) asm volatile("" ::: "memory"); }
        LDS_WAIT(); __builtin_amdgcn_s_barrier(); asm volatile("" ::: "memory");
        const int row = wid * 32 + (lane & 31);
        if (lane < 32) { const f32x4 p = *(const LAS f32x4*)(P + row * 4);
            __hip_atomic_store(slots + ((size_t)(u.pm * BM + row)) * 8 + u.pn, (p[0] + p[1]) + (p[2] + p[3]), __ATOMIC_RELAXED, __HIP_MEMORY_SCOPE_AGENT); }
        asm volatile("s_waitcnt vmcnt(0)" ::: "memory");
        if (lane == 0) __hip_atomic_fetch_add(cnt + 64 * u.pm, 1u, __ATOMIC_RELAXED, __HIP_MEMORY_SCOPE_AGENT);
        if (wid == 0) {
            unsigned sp = 0u;
            while ((unsigned)__builtin_amdgcn_readfirstlane(__hip_atomic_load(cnt + 64 * u.pm, __ATOMIC_RELAXED, __HIP_MEMORY_SCOPE_AGENT)) < 64u) { __builtin_amdgcn_s_sleep(2); if (++sp > (1u << 20)) break; }
            __builtin_amdgcn_fence(__ATOMIC_ACQUIRE, "agent");
        }
        asm volatile("s_waitcnt vmcnt(0) lgkmcnt(0)" ::: "memory"); __builtin_amdgcn_s_barrier(); asm volatile("" ::: "memory");
        if (lane < 32) { const float* sl = slots + ((size_t)(u.pm * BM + row)) * 8; float tot = 0.f;
#pragma unroll
            for (int t = 0; t < 8; ++t) tot += __hip_atomic_load(sl + t, __ATOMIC_RELAXED, __HIP_MEMORY_SCOPE_AGENT);
            S[row] = rsqrtf(tot * (1.f / DM) + EPS); }
        LDS_WAIT(); __builtin_amdgcn_s_barrier(); asm volatile("" ::: "memory");
        f32x4 gv[2][2];
#pragma unroll
        for (int bj = 0; bj < 2; ++bj)
#pragma unroll
            for (int n = 0; n < 2; ++n) gv[bj][n] = *(const f32x4*)(g + col0 + bj * HALF + 4 * n);
#pragma unroll
        for (int ai = 0; ai < 2; ++ai)
#pragma unroll
            for (int m = 0; m < 4; ++m) { const int rl = ai * HALF + wr * 64 + m * 16 + fr; const float rs = S[rl]; float* dst = yp + (size_t)(u.pm * BM + rl) * DM + col0;
#pragma unroll
                for (int bj = 0; bj < 2; ++bj) { *(f32x4*)(dst + bj * HALF) = acc[ai][bj][m][0] * rs * gv[bj][0]; *(f32x4*)(dst + bj * HALF + 4) = acc[ai][bj][m][1] * rs * gv[bj][1]; } }
        LDS_WAIT(); __builtin_amdgcn_s_barrier(); asm volatile("" ::: "memory");
    }
};

template <class Epi, class Sched, bool ALIGN_EPI>
__device__ __forceinline__ void gemm_phase(LAS unsigned char* lds, const int lda, const int ldb, const int K, const Sched& S, const Epi& E) {
    const int tid = threadIdx.x, wid = __builtin_amdgcn_readfirstlane(tid >> 6), lane = tid & 63, wr = wid >> 2, wc = wid & 3, fr = lane & 15, fq = lane >> 4;
    const int nt = K / BK;
    unsigned voffA[2], voffB[2];
#pragma unroll
    for (int i = 0; i < 2; ++i) { int R, C; stage_rc(tid * 16 + i * 8192, R, C); const int Rb = Epi::PERM ? ((R & ~31) + perm32(R & 31)) : R;
        voffA[i] = (unsigned)(R * lda + C) * 2u; voffB[i] = (unsigned)(Rb * ldb + C) * 2u; }
    const size_t kstep = (size_t)(BK * 2);
    const size_t hA = (size_t)HALF * lda * 2, hB = (size_t)HALF * ldb * 2;
    const unsigned ldsw = (unsigned)wid * 1024u;
    const int aoff = lds_byte(wr * 64 + fr, fq * 8), boff = lds_byte(wc * 32 + fr, fq * 8);
#define PG8_SA(b, h) (((b) * 2 + (h)) * HTB)
#define PG8_SB(b, h) ((4 + (b) * 2 + (h)) * HTB)
#define PG8_STAGE(bufoff, gbase, voff) do { _Pragma("unroll") for (int _i = 0; _i < 2; ++_i) \
        __builtin_amdgcn_global_load_lds((const unsigned*)((const char*)(gbase) + (voff)[_i]), (LAS unsigned*)(lds + (bufoff) + ldsw + _i * 8192), 16, 0, 0); } while (0)
#define PG8_LDA(dst, b, h) do { _Pragma("unroll") for (int m = 0; m < 4; ++m) _Pragma("unroll") for (int k = 0; k < 2; ++k) dst[m][k] = *(const LAS bf16x8*)(lds + PG8_SA(b, h) + aoff + m * 2048 + k * 1024); } while (0)
#define PG8_LDB(dst, b, h) do { _Pragma("unroll") for (int n = 0; n < 2; ++n) _Pragma("unroll") for (int k = 0; k < 2; ++k) dst[n][k] = *(const LAS bf16x8*)(lds + PG8_SB(b, h) + boff + n * 2048 + k * 1024); } while (0)
#define PG8_MMA(ai, bj, At, Bt) do { __builtin_amdgcn_s_setprio(1); _Pragma("unroll") for (int m = 0; m < 4; ++m) _Pragma("unroll") for (int n = 0; n < 2; ++n) _Pragma("unroll") for (int k = 0; k < 2; ++k) \
        acc[ai][bj][m][n] = __builtin_amdgcn_mfma_f32_16x16x32_bf16(Bt[n][k], At[m][k], acc[ai][bj][m][n], 0, 0, 0); __builtin_amdgcn_s_setprio(0); } while (0)
#define PG8_WAIT_V(n) asm volatile("s_waitcnt vmcnt(" #n ")" ::: "memory")
#define PG8_WAIT_L(n) asm volatile("s_waitcnt lgkmcnt(" #n ")" ::: "memory")
#define PG8_BAR __builtin_amdgcn_s_barrier()
#define PG8_SCHED __builtin_amdgcn_sched_barrier(0)
    Unit cur, nxt; int ui = 0;
    if (!S.next(0, cur)) return;
    Acc acc;
#pragma unroll
    for (int a = 0; a < 2; ++a)
#pragma unroll
        for (int b = 0; b < 2; ++b)
#pragma unroll
            for (int m = 0; m < 4; ++m)
#pragma unroll
                for (int n = 0; n < 2; ++n) acc[a][b][m][n] = (f32x4){0.f, 0.f, 0.f, 0.f};
    bf16x8 At[4][2], B0[2][2], B1[2][2];
    const char* cA = S.aptr(cur); const char* cB = S.bptr(cur);
    PG8_STAGE(PG8_SB(0, 0), cB, voffB); PG8_STAGE(PG8_SB(0, 1), cB + hB, voffB); PG8_STAGE(PG8_SA(0, 0), cA, voffA); PG8_STAGE(PG8_SA(0, 1), cA + hA, voffA);
    if (wr == 1) PG8_BAR;
    PG8_WAIT_V(2); PG8_BAR;
    PG8_STAGE(PG8_SB(1, 0), cB + kstep, voffB); PG8_STAGE(PG8_SA(1, 0), cA + kstep, voffA); PG8_STAGE(PG8_SB(1, 1), cB + hB + kstep, voffB);
    PG8_WAIT_V(6); PG8_BAR;
    for (;;) {
        const bool has_next = S.next(ui + 1, nxt);
        const char* nA = has_next ? S.aptr(nxt) : cA; const char* nB = has_next ? S.bptr(nxt) : cB;
#pragma unroll 1
        for (int t = 0; t < nt; t += 2) {
            const bool last = (t == nt - 2);
            const char* a1 = cA + (size_t)(t + 1) * kstep;
            const char* a2 = last ? nA : cA + (size_t)(t + 2) * kstep; const char* b2 = last ? nB : cB + (size_t)(t + 2) * kstep;
            const char* a3 = a2 + kstep; const char* b3 = b2 + kstep;
            PG8_LDB(B0, 0, 0); PG8_LDB(B1, 0, 1); PG8_SCHED; PG8_LDA(At, 0, 0); PG8_STAGE(PG8_SA(1, 1), a1 + hA, voffA);
            PG8_WAIT_V(8); PG8_WAIT_L(0); PG8_BAR; PG8_MMA(0, 0, At, B0); PG8_MMA(0, 1, At, B1); PG8_BAR; PG8_SCHED;
            PG8_LDA(At, 0, 1); PG8_STAGE(PG8_SB(0, 0), b2, voffB); PG8_STAGE(PG8_SB(0, 1), b2 + hB, voffB); PG8_STAGE(PG8_SA(0, 0), a2, voffA);
            PG8_WAIT_V(8); PG8_WAIT_L(0); PG8_BAR; PG8_MMA(1, 0, At, B0); PG8_MMA(1, 1, At, B1); PG8_BAR; PG8_SCHED;
            PG8_LDB(B0, 1, 0); PG8_LDB(B1, 1, 1); PG8_SCHED; PG8_LDA(At, 1, 0); PG8_STAGE(PG8_SA(0, 1), a2 + hA, voffA);
            PG8_WAIT_V(8); PG8_WAIT_L(0); PG8_BAR; PG8_MMA(0, 0, At, B0); PG8_MMA(0, 1, At, B1); PG8_BAR; PG8_SCHED;
            PG8_LDA(At, 1, 1); PG8_STAGE(PG8_SB(1, 0), b3, voffB); PG8_STAGE(PG8_SB(1, 1), b3 + hB, voffB); PG8_STAGE(PG8_SA(1, 0), a3, voffA);
            PG8_WAIT_V(8); PG8_WAIT_L(0); PG8_BAR; PG8_MMA(1, 0, At, B0); PG8_MMA(1, 1, At, B1); PG8_BAR; PG8_SCHED;
        }
        if constexpr (ALIGN_EPI) { if (wr == 0) PG8_BAR; }
        if constexpr (!Epi::AFTER_DRAIN) { E(acc, cur, wr, wc, fr, fq); }
        if (!has_next) break;
#pragma unroll
        for (int a = 0; a < 2; ++a)
#pragma unroll
            for (int b = 0; b < 2; ++b)
#pragma unroll
                for (int m = 0; m < 4; ++m)
#pragma unroll
                    for (int n = 0; n < 2; ++n) acc[a][b][m][n] = (f32x4){0.f, 0.f, 0.f, 0.f};
        cur = nxt; cA = nA; cB = nB; ++ui;
        if constexpr (ALIGN_EPI) { if (wr == 1) PG8_BAR; }
    }
    PG8_WAIT_V(0);
    if constexpr (!ALIGN_EPI) { if (wr == 0) PG8_BAR; }
    PG8_BAR;
    if constexpr (Epi::AFTER_DRAIN) { E.fused(acc, cur, wr, wc, fr, fq, lds, wid, lane); }
#undef PG8_SA
#undef PG8_SB
#undef PG8_STAGE
#undef PG8_LDA
#undef PG8_LDB
#undef PG8_MMA
#undef PG8_WAIT_V
#undef PG8_WAIT_L
#undef PG8_BAR
#undef PG8_SCHED
}
}

struct Args { const float* in[35]; float* out; unsigned char* ws; int ph_lo, ph_hi; };
enum { I_XP = 0, I_XS, I_MEM, I_SRGH, I_SRGC, I_SMLC, I_SMLN, I_SMLM, I_CK, I_CV, I_GMIX, I_WIN, I_CONVW, I_CONVB, I_WRGA, I_BRGA, I_WRGX, I_BRGX, I_LAM,
       I_BMLI, I_BMLF, I_GRG, I_GML, I_WOUT, I_GXA, I_GMEM, I_WQ, I_WK, I_WV, I_WO, I_GFFN, I_WG, I_WU, I_WD, I_GFIN };

__device__ __forceinline__ void tr_item(const float* W, int ldw, bf16_t* dst, int ldd, LAS float* scr, int lane) {
#pragma unroll
    for (int hf = 0; hf < 2; ++hf) { float v[32];
#pragma unroll
        for (int kk = 0; kk < 32; ++kk) v[kk] = W[(size_t)(hf * 32 + kk) * ldw + lane];
#pragma unroll
        for (int kk = 0; kk < 32; ++kk) scr[(hf * 32 + kk) * 65 + lane] = v[kk]; }
    LDS_WAIT();
    const int c = lane & 7;
#pragma unroll
    for (int j = 0; j < 8; ++j) { const int n = (lane >> 3) + 8 * j; const LAS float* s = scr + (8 * c) * 65 + n;
        u32x4 o; o.x = cvt_pk_bf16(s[0], s[65]); o.y = cvt_pk_bf16(s[2 * 65], s[3 * 65]); o.z = cvt_pk_bf16(s[4 * 65], s[5 * 65]); o.w = cvt_pk_bf16(s[6 * 65], s[7 * 65]);
        *(u32x4*)(dst + (size_t)n * ldd + 8 * c) = o; }
    LDS_WAIT();
}
template <int MAP> __device__ __forceinline__ void tr_mat(int it, const float* W, int ldw, int ncols, bf16_t* dst, int ldd, LAS float* scr, int lane) {
    const int nblk = ncols / 64, kb = it / nblk, nb = it % nblk, k0 = kb * 64, n0 = nb * 64;
    const int drow = MAP == 0 ? n0 : ((n0 >> 7) * 256 + (n0 & 127) + (MAP == 2 ? 128 : 0));
    tr_item(W + (size_t)k0 * ldw + n0, ldw, dst + (size_t)drow * ldd + k0, ldd, scr, lane);
}
__device__ __forceinline__ void pro_row(const float* xrow, const float* g, bf16_t* orow, const float* wg, float* gates_out, int lane) {
    f32x4 v[8]; float ss = 0.f;
#pragma unroll
    for (int j = 0; j < 8; ++j) { v[j] = *(const f32x4*)(xrow + 4 * lane + 256 * j); ss += (v[j][0] * v[j][0] + v[j][1] * v[j][1]) + (v[j][2] * v[j][2] + v[j][3] * v[j][3]); }
    ss = wave_sum(ss); const float rstd = rsqrtf(ss * (1.f / DM) + EPS);
    f32x4 ga0 = {0.f, 0.f, 0.f, 0.f}, ga1 = {0.f, 0.f, 0.f, 0.f};
#pragma unroll
    for (int j = 0; j < 8; ++j) { const f32x4 gj = *(const f32x4*)(g + 4 * lane + 256 * j); v[j] = v[j] * rstd * gj;
        u32x2 w; w.x = cvt_pk_bf16(v[j][0], v[j][1]); w.y = cvt_pk_bf16(v[j][2], v[j][3]); *(u32x2*)(orow + 4 * lane + 256 * j) = w;
        if (wg) {
#pragma unroll
            for (int e = 0; e < 4; ++e) { const float* wp = wg + ((j * 4 + e) * 64 + lane) * 4; ga0 += v[j][e] * *(const f32x4*)wp; ga1 += v[j][e] * *(const f32x4*)(wp + 8192); } } }
    if (wg) {
#pragma unroll
        for (int q = 0; q < 4; ++q) { ga0[q] = wave_sum(ga0[q]); ga1[q] = wave_sum(ga1[q]); }
        if (lane == 0) { *(f32x4*)gates_out = ga0; *(f32x4*)(gates_out + 4) = ga1; } }
}
__device__ __forceinline__ void phase_prologue(const Args& a, unsigned char* lds_, int G) {
    const int tid = threadIdx.x, lane = tid & 63, wave = tid >> 6;
    LAS float* scr = (LAS float*)((LAS unsigned char*)lds_ + wave * 16640);
    const int gw = blockIdx.x * 8 + wave, NGW = G * 8;
    unsigned char* ws = a.ws;
    constexpr int I_IN = 32 * 80, I_SQ = 32 * 32, I_RG = 8 * 4;
    constexpr int NITEMS = I_IN + 2 * I_SQ + 2 * I_RG;
    for (int it = gw; it < NITEMS; it += NGW) {
        int r = it;
        if (r < I_IN) { tr_mat<0>(r, a.in[I_WIN], INW, ZW, (bf16_t*)(ws + WS_WIN), DM, scr, lane); continue; } r -= I_IN;
        if (r < I_SQ) { tr_mat<0>(r, a.in[I_WK], DM, DM, (bf16_t*)(ws + WS_WKV), DM, scr, lane); continue; } r -= I_SQ;
        if (r < I_SQ) { tr_mat<0>(r, a.in[I_WV], DM, DM, (bf16_t*)(ws + WS_WKV) + (size_t)DM * DM, DM, scr, lane); continue; } r -= I_SQ;
        if (r < I_RG) { const int blk = r >> 2; tr_mat<0>(r & 3, a.in[I_WRGA] + blk * 16384, 128, 128, (bf16_t*)(ws + WS_WRG) + blk * 32768, 128, scr, lane); continue; } r -= I_RG;
        { const int blk = r >> 2; tr_mat<0>(r & 3, a.in[I_WRGX] + blk * 16384, 128, 128, (bf16_t*)(ws + WS_WRG) + blk * 32768 + 128 * 128, 128, scr, lane); }
    }
    bf16_t* ABUF = (bf16_t*)(ws + WS_ABUF); float* GATES = (float*)(ws + WS_GATES);
    __syncthreads();
    float* wgl = (float*)lds_;
    for (int idx = tid; idx < 4096; idx += 512) { const int k = idx >> 1, hf = idx & 1; const int slot = ((k >> 8) * 4 + (k & 3)) * 64 + ((k & 255) >> 2);
        *(f32x4*)(wgl + hf * 8192 + slot * 4) = *(const f32x4*)(a.in[I_WIN] + (size_t)k * INW + ZW + hf * 4); }
    __syncthreads();
    for (int r = gw; r < MA; r += NGW) {
        if (r < MV) { const float* xrow = r < NP ? a.in[I_XP] + (size_t)r * DM : a.in[I_XS] + (size_t)(r - NP) * DM;
            pro_row(xrow, a.in[I_GMIX], ABUF + (size_t)r * DM, wgl, GATES + (size_t)r * 8, lane); }
        else {
#pragma unroll
            for (int j = 0; j < 8; ++j) *(u32x2*)(ABUF + (size_t)r * DM + 4 * lane + 256 * j) = (u32x2){0u, 0u}; }
    }
    for (int r = gw; r < 1024; r += NGW) pro_row(a.in[I_MEM] + (size_t)r * DM, a.in[I_GMEM], (bf16_t*)(ws + WS_MN) + (size_t)r * DM, nullptr, nullptr, lane);
}

constexpr int LATE_ITEMS = 3 * 32 * 88 + 3 * 32 * 32;
__device__ __forceinline__ void late_transposes(const Args& a, unsigned char* lds_, int first, int last, int wslot, int nslots) {
    const int lane = threadIdx.x & 63, wave = threadIdx.x >> 6;
    LAS float* scr = (LAS float*)((LAS unsigned char*)lds_ + wave * 16640);
    constexpr int I_GU = 32 * 88;
    for (int it = first + wslot; it < last; it += nslots) {
        int r = it;
        if (r < I_GU) { tr_mat<1>(r, a.in[I_WG], DFF, DFF, (bf16_t*)(a.ws + WS_WGU), DM, scr, lane); continue; } r -= I_GU;
        if (r < I_GU) { tr_mat<2>(r, a.in[I_WU], DFF, DFF, (bf16_t*)(a.ws + WS_WGU), DM, scr, lane); continue; } r -= I_GU;
        if (r < I_GU) { tr_mat<0>(r, a.in[I_WD], DM, DM, (bf16_t*)(a.ws + WS_WD), DFF, scr, lane); continue; } r -= I_GU;
        if (r < 1024) { tr_mat<0>(r, a.in[I_WOUT], DM, DM, (bf16_t*)(a.ws + WS_WOUT), DM, scr, lane); continue; } r -= 1024;
        if (r < 1024) { tr_mat<0>(r, a.in[I_WQ], DM, DM, (bf16_t*)(a.ws + WS_WQ), DM, scr, lane); continue; } r -= 1024;
        tr_mat<0>(r, a.in[I_WO], DM, DM, (bf16_t*)(a.ws + WS_WO), DM, scr, lane);
    }
}

__device__ __forceinline__ void unpack8(const u32x4 w, float* f) { f[0] = bflo(w.x); f[1] = bfhi(w.x); f[2] = bflo(w.y); f[3] = bfhi(w.y); f[4] = bflo(w.z); f[5] = bfhi(w.z); f[6] = bflo(w.w); f[7] = bfhi(w.w); }

__device__ __forceinline__ void rg_item(const Args& a, unsigned char* lds_, int b, int blk, int seg) {
    const int tid = threadIdx.x, lane = tid & 63, wave = tid >> 6;
    unsigned char* ws = a.ws;
    const bf16_t* Z = (const bf16_t*)(ws + WS_Z); float* YPRE = (float*)(ws + WS_YPRE); float* CPRE = (float*)(ws + WS_CPRE); float* RGE = (float*)(ws + WS_RGE);
    bf16_t* XRb = (bf16_t*)lds_;
    float* XRf = (float*)(lds_ + 17408);
    float* Gs = (float*)(lds_ + 17408 + 32768);
    bf16x8 bfr[2][4];
    { const bf16_t* wrg = (const bf16_t*)(ws + WS_WRG) + blk * 32768;
#pragma unroll
      for (int nt = 0; nt < 2; ++nt)
#pragma unroll
          for (int ks = 0; ks < 4; ++ks) bfr[nt][ks] = *(const bf16x8*)(wrg + (wave * 32 + nt * 16 + (lane & 15)) * 128 + ks * 32 + (lane >> 4) * 8); }
    const int c8 = tid & 15, chb = blk * 128 + c8 * 8;
    float cw[4][8], cb[8];
#pragma unroll
    for (int e = 0; e < 8; ++e) { cb[e] = a.in[I_CONVB][chb + e];
#pragma unroll
        for (int j = 0; j < 4; ++j) cw[j][e] = a.in[I_CONVW][j * 1024 + chb + e]; }
    float bias[2];
#pragma unroll
    for (int nt = 0; nt < 2; ++nt) { const int col = wave * 32 + nt * 16 + (lane & 15); bias[nt] = col < 128 ? a.in[I_BRGA][blk * 128 + col] : a.in[I_BRGX][blk * 128 + col - 128]; }
    const int cc = tid & 127;
    float sp; { const float nl = -a.in[I_LAM][blk * 128 + cc]; sp = nl > 20.f ? nl : log1pf(__expf(nl)); }
    float hcar = 0.f, pcar = 1.f;
    u32x4 zpre[2][4];
    { const int t0 = seg * 512;
#pragma unroll
      for (int i = 0; i < 2; ++i)
#pragma unroll
          for (int j = 0; j < 4; ++j) { const int tt = t0 + ((tid + 512 * i) >> 4) - 3 + j; zpre[i][j] = tt >= 0 ? *(const u32x4*)(Z + ((size_t)b * SEQ + tt) * ZW + chb) : (u32x4){0u, 0u, 0u, 0u}; } }
    for (int tile = 0; tile < 8; ++tile) {
        const int t0 = seg * 512 + tile * 64; const size_t R0 = (size_t)b * SEQ + t0;
#pragma unroll
        for (int i = 0; i < 2; ++i) { const int t = (tid + 512 * i) >> 4; float xr[8];
#pragma unroll
            for (int e = 0; e < 8; ++e) xr[e] = cb[e];
#pragma unroll
            for (int j = 0; j < 4; ++j) { float z[8]; unpack8(zpre[i][j], z);
#pragma unroll
                for (int e = 0; e < 8; ++e) xr[e] += cw[j][e] * z[e]; }
            *(f32x4*)(XRf + t * 128 + c8 * 8) = (f32x4){xr[0], xr[1], xr[2], xr[3]}; *(f32x4*)(XRf + t * 128 + c8 * 8 + 4) = (f32x4){xr[4], xr[5], xr[6], xr[7]};
            u32x4 w; w.x = cvt_pk_bf16(xr[0], xr[1]); w.y = cvt_pk_bf16(xr[2], xr[3]); w.z = cvt_pk_bf16(xr[4], xr[5]); w.w = cvt_pk_bf16(xr[6], xr[7]);
            *(u32x4*)(XRb + t * 136 + c8 * 8) = w; }
        if (tile < 7) {
#pragma unroll
            for (int i = 0; i < 2; ++i)
#pragma unroll
                for (int j = 0; j < 4; ++j) { const int tt = t0 + 64 + ((tid + 512 * i) >> 4) - 3 + j; zpre[i][j] = *(const u32x4*)(Z + ((size_t)b * SEQ + tt) * ZW + chb); } }
        LBAR();
        { f32x4 acc[4][2];
#pragma unroll
          for (int mt = 0; mt < 4; ++mt)
#pragma unroll
              for (int nt = 0; nt < 2; ++nt) acc[mt][nt] = (f32x4){0.f, 0.f, 0.f, 0.f};
#pragma unroll
          for (int mt = 0; mt < 4; ++mt)
#pragma unroll
              for (int ks = 0; ks < 4; ++ks) { const bf16x8 af = *(const bf16x8*)(XRb + (mt * 16 + (lane & 15)) * 136 + ks * 32 + (lane >> 4) * 8);
#pragma unroll
                  for (int nt = 0; nt < 2; ++nt) acc[mt][nt] = __builtin_amdgcn_mfma_f32_16x16x32_bf16(af, bfr[nt][ks], acc[mt][nt], 0, 0, 0); }
#pragma unroll
          for (int mt = 0; mt < 4; ++mt)
#pragma unroll
              for (int nt = 0; nt < 2; ++nt)
#pragma unroll
                  for (int j = 0; j < 4; ++j) Gs[(mt * 16 + (lane >> 4) * 4 + j) * 256 + wave * 32 + nt * 16 + (lane & 15)] = sigmoidf_(acc[mt][nt][j] + bias[nt]); }
        LBAR();
#pragma unroll 4
        for (int i = 0; i < 16; ++i) { const int t = (tid + 512 * i) >> 7; const float r = Gs[t * 256 + cc], ig = Gs[t * 256 + 128 + cc];
            const float la = -8.f * r * sp, av = __expf(la), mult = __builtin_amdgcn_sqrtf(fmaxf(1.f - __expf(2.f * la), 0.f));
            Gs[t * 256 + cc] = av; Gs[t * 256 + 128 + cc] = mult * ig * XRf[t * 128 + cc]; }
        LBAR();
        if (tid < 128) {
#pragma unroll 8
            for (int t = 0; t < 64; ++t) { const float av = Gs[t * 256 + tid]; hcar = av * hcar + Gs[t * 256 + 128 + tid]; pcar *= av; Gs[t * 256 + tid] = hcar; Gs[t * 256 + 128 + tid] = pcar; } }
        LBAR();
#pragma unroll
        for (int i = 0; i < 2; ++i) { const int t = (tid + 512 * i) >> 4; const float* gp = Gs + t * 256 + c8 * 8;
            float* yp = YPRE + (R0 + t) * 1024 + chb; *(f32x4*)yp = *(const f32x4*)gp; *(f32x4*)(yp + 4) = *(const f32x4*)(gp + 4);
            float* pp = CPRE + (R0 + t) * 1024 + chb; *(f32x4*)pp = *(const f32x4*)(gp + 128); *(f32x4*)(pp + 4) = *(const f32x4*)(gp + 132); }
    }
    if (tid < 128) { RGE[((size_t)(b * 4 + seg) * 2 + 0) * 1024 + blk * 128 + tid] = hcar; RGE[((size_t)(b * 4 + seg) * 2 + 1) * 1024 + blk * 128 + tid] = pcar; }
    if (seg == 3 && tid < 384) { const int j = tid >> 7, c = tid & 127; a.out[O_PRGC + ((size_t)b * 3 + j) * 1024 + blk * 128 + c] = bf2f(Z[((size_t)b * SEQ + 2045 + j) * ZW + blk * 128 + c]); }
    __syncthreads();
}

__device__ __forceinline__ void ml_item(const Args& a, unsigned char* lds_, int b, int h, int sl, int seg) {
    const int tid = threadIdx.x, lane = tid & 63, wave = tid >> 6, l15 = lane & 15, lq = lane >> 4;
    unsigned char* ws = a.ws;
    const bf16_t* Z = (const bf16_t*)(ws + WS_Z); const float* GATES = (const float*)(ws + WS_GATES); float* HPRE = (float*)(ws + WS_HPRE); float* MLS = (float*)(ws + WS_MLS);
    bf16_t* Qs = (bf16_t*)lds_;
    bf16_t* Ks = (bf16_t*)(lds_ + 17408);
    bf16_t* Vt = (bf16_t*)(lds_ + 34816);
    bf16_t* Kwt = (bf16_t*)(lds_ + 46336);
    bf16_t* Ss = (bf16_t*)(lds_ + 64768);
    bf16_t* Ctb = (bf16_t*)(lds_ + 73984);
    float* Out = (float*)(lds_ + 95744);
    float* Aa = (float*)(lds_ + 116480);
    float* Am = Aa + 2048;
    float* Bc = Am + 2048;
    const float scale = 0.08838834764831845f;
    for (int i = tid; i < 80 * 136; i += 512) Ctb[i] = 0;
    for (int i = tid; i < 16 * 72; i += 512) Vt[64 * 72 + i] = (i < 72) ? (bf16_t)0x3F80 : (bf16_t)0;
    { const float bi = a.in[I_BMLI][h], bff = a.in[I_BMLF][h];
#pragma unroll
      for (int cI = 0; cI < 4; ++cI) { const int tok = (wave + 8 * cI) * 64 + lane; const size_t R = (size_t)b * SEQ + tok;
          const float gi = GATES[R * 8 + h] + bi, gf = GATES[R * 8 + 4 + h] + bff;
          const float lf = fminf(gf, 0.f) - log1pf(__expf(-fabsf(gf)));
          float bc = lf;
#pragma unroll
          for (int o = 1; o < 64; o <<= 1) { const float t = __shfl_up(bc, o); if (lane >= o) bc += t; }
          const float av = gi - bc; float am = av;
#pragma unroll
          for (int o = 1; o < 64; o <<= 1) { const float t = __shfl_up(am, o); if (lane >= o) am = fmaxf(am, t); }
          Aa[tok] = av; Am[tok] = am; Bc[tok] = bc; } }
    f32x4 cacc[5];
#pragma unroll
    for (int mt = 0; mt < 5; ++mt) cacc[mt] = (f32x4){0.f, 0.f, 0.f, 0.f};
    float m_prev = 0.f, m_old = 0.f, m_seg = 0.f, Fs = 0.f, Fs_old = 0.f;
    const int pt = tid & 63, pd8 = tid >> 6;
    u32x4 qpre[2], kpre[2], vpre;
#define ML_LOAD(Q, K, V, R0_) do { _Pragma("unroll") for (int i = 0; i < 2; ++i) { Q[i] = *(const u32x4*)(Z + ((R0_) + pt) * ZW + 2048 + h * 128 + (2 * pd8 + i) * 8); K[i] = *(const u32x4*)(Z + ((R0_) + pt) * ZW + 2560 + h * 128 + (2 * pd8 + i) * 8); } \
        V = *(const u32x4*)(Z + ((R0_) + pt) * ZW + 3072 + h * 256 + sl * 64 + pd8 * 8); } while (0)
    { const size_t R0 = (size_t)b * SEQ + seg * 1024; ML_LOAD(qpre, kpre, vpre, R0); }
    __syncthreads();
    for (int c = 0; c < seg * 16; ++c) m_prev = Bc[c * 64 + 63] + fmaxf(m_prev, Am[c * 64 + 63]);
    m_seg = m_prev; m_old = m_prev;
#pragma unroll 1
    for (int ci = 0; ci <= 16; ++ci) {
        const int ch = seg * 16 + ci, c0 = ch * 64;
        const int cq = ci < 16 ? c0 : 0; const float F = Bc[cq + 63], m_new = F + fmaxf(m_prev, Am[cq + 63]), dec = __expf(F + m_prev - m_new);
        if (ci < 16) { const float wend = __expf(F + Aa[c0 + pt] - m_new) * scale;
#pragma unroll
          for (int i = 0; i < 2; ++i) { const int d8 = 2 * pd8 + i;
              *(u32x4*)(Qs + pt * 136 + d8 * 8) = qpre[i]; *(u32x4*)(Ks + pt * 136 + d8 * 8) = kpre[i];
              float kf[8]; unpack8(kpre[i], kf); bf16_t* kp = Kwt + (d8 * 8) * 72 + pt;
#pragma unroll
              for (int e = 0; e < 8; ++e) kp[e * 72] = f2bf(kf[e] * wend); }
          bf16_t* vp = Vt + (pd8 * 8) * 72 + pt; const u32x4 w = vpre;
          vp[0] = (bf16_t)(w.x & 0xffff); vp[72] = (bf16_t)(w.x >> 16); vp[144] = (bf16_t)(w.y & 0xffff); vp[216] = (bf16_t)(w.y >> 16);
          vp[288] = (bf16_t)(w.z & 0xffff); vp[360] = (bf16_t)(w.z >> 16); vp[432] = (bf16_t)(w.w & 0xffff); vp[504] = (bf16_t)(w.w >> 16); }
        if (ci > 0) { const size_t R1 = (size_t)b * SEQ + c0 - 64;
#pragma unroll
            for (int mt = 0; mt < 5; ++mt)
#pragma unroll
                for (int j = 0; j < 4; ++j) Ctb[(mt * 16 + lq * 4 + j) * 136 + wave * 16 + l15] = f2bf(cacc[mt][j]);
#pragma unroll
            for (int i = 0; i < 8; ++i) { const int idx = tid + 512 * i, v = idx & 63, t = idx >> 6; HPRE[(R1 + t) * 1024 + h * 256 + sl * 64 + v] = Out[t * 81 + v]; }
            if (sl == 0 && tid < 64) { const int t = tid; const float mtv = Bc[c0 - 64 + t] + fmaxf(m_old, Am[c0 - 64 + t]);
                f32x4 o; o[0] = Out[t * 81 + 64]; o[1] = __expf(-mtv); o[2] = seg ? __expf(Fs_old + Bc[c0 - 64 + t] + m_seg - mtv) : 0.f; o[3] = 0.f;
                *(f32x4*)(MLS + ((R1 + t) * 4 + h) * 4) = o; } }
        if (ci == 16) break;
        if (ci < 15) { const size_t R0 = (size_t)b * SEQ + c0 + 64; ML_LOAD(qpre, kpre, vpre, R0); }
        LBAR();
        { const int mt = wave >> 1; bf16x8 afq[4]; f32x4 acc2[2] = {{0.f, 0.f, 0.f, 0.f}, {0.f, 0.f, 0.f, 0.f}};
#pragma unroll
          for (int ks = 0; ks < 4; ++ks) afq[ks] = *(const bf16x8*)(Qs + (mt * 16 + l15) * 136 + ks * 32 + lq * 8);
#pragma unroll
          for (int ks = 0; ks < 4; ++ks)
#pragma unroll
              for (int n = 0; n < 2; ++n) { const int nt = 2 * (wave & 1) + n; const bf16x8 bfv = *(const bf16x8*)(Ks + (nt * 16 + l15) * 136 + ks * 32 + lq * 8);
                  acc2[n] = __builtin_amdgcn_mfma_f32_16x16x32_bf16(afq[ks], bfv, acc2[n], 0, 0, 0); }
#pragma unroll
          for (int n = 0; n < 2; ++n) { const int nt = 2 * (wave & 1) + n; const int sI = nt * 16 + l15; const float as = Aa[c0 + sI];
#pragma unroll
              for (int j = 0; j < 4; ++j) { const int t = mt * 16 + lq * 4 + j; const float v = (sI <= t) ? acc2[n][j] * scale * __expf(as - fmaxf(m_prev, Am[c0 + t])) : 0.f; Ss[t * 72 + sI] = f2bf(v); } } }
        LBAR();
        { const int mt = wave & 3, nt0 = wave < 4 ? 0 : 3, nn = wave < 4 ? 3 : 2; bf16x8 afq[4], afs[2]; f32x4 acc3[3];
#pragma unroll
          for (int n = 0; n < 3; ++n) acc3[n] = (f32x4){0.f, 0.f, 0.f, 0.f};
#pragma unroll
          for (int ks = 0; ks < 4; ++ks) afq[ks] = *(const bf16x8*)(Qs + (mt * 16 + l15) * 136 + ks * 32 + lq * 8);
#pragma unroll
          for (int ks = 0; ks < 2; ++ks) afs[ks] = *(const bf16x8*)(Ss + (mt * 16 + l15) * 72 + ks * 32 + lq * 8);
#pragma unroll
          for (int ks = 0; ks < 4; ++ks)
#pragma unroll
              for (int n = 0; n < 3; ++n) if (n < nn) { const bf16x8 bfv = *(const bf16x8*)(Ctb + ((nt0 + n) * 16 + l15) * 136 + ks * 32 + lq * 8);
                  acc3[n] = __builtin_amdgcn_mfma_f32_16x16x32_bf16(afq[ks], bfv, acc3[n], 0, 0, 0); }
          float scv[4];
#pragma unroll
          for (int j = 0; j < 4; ++j) scv[j] = __expf(m_prev - fmaxf(m_prev, Am[c0 + mt * 16 + lq * 4 + j]));
#pragma unroll
          for (int n = 0; n < 3; ++n)
#pragma unroll
              for (int j = 0; j < 4; ++j) acc3[n][j] *= scv[j];
#pragma unroll
          for (int ks = 0; ks < 2; ++ks)
#pragma unroll
              for (int n = 0; n < 3; ++n) if (n < nn) { const bf16x8 bfv = *(const bf16x8*)(Vt + ((nt0 + n) * 16 + l15) * 72 + ks * 32 + lq * 8);
                  acc3[n] = __builtin_amdgcn_mfma_f32_16x16x32_bf16(afs[ks], bfv, acc3[n], 0, 0, 0); }
#pragma unroll
          for (int n = 0; n < 3; ++n) if (n < nn) {
#pragma unroll
              for (int j = 0; j < 4; ++j) Out[(mt * 16 + lq * 4 + j) * 81 + (nt0 + n) * 16 + l15] = acc3[n][j]; } }
#pragma unroll
        for (int mt = 0; mt < 5; ++mt) { cacc[mt] = cacc[mt] * dec;
#pragma unroll
            for (int ks = 0; ks < 2; ++ks) { const bf16x8 af = *(const bf16x8*)(Vt + (mt * 16 + l15) * 72 + ks * 32 + lq * 8), bfv = *(const bf16x8*)(Kwt + (wave * 16 + l15) * 72 + ks * 32 + lq * 8);
                cacc[mt] = __builtin_amdgcn_mfma_f32_16x16x32_bf16(af, bfv, cacc[mt], 0, 0, 0); } }
        m_old = m_prev; m_prev = m_new; Fs_old = Fs; Fs += F;
        LBAR();
    }
#undef ML_LOAD
    if (seg == 0) {
        float* CINF = (float*)(ws + WS_CINF) + (size_t)((b * 4 + h) * 4 + sl) * 80 * 128; bf16_t* CIN = (bf16_t*)(ws + WS_CIN) + (size_t)((b * 4 + h) * 4 + sl) * 80 * 128;
#pragma unroll
        for (int mt = 0; mt < 5; ++mt)
#pragma unroll
            for (int j = 0; j < 4; ++j) { const int o = (mt * 16 + lq * 4 + j) * 128 + wave * 16 + l15; CINF[o] = cacc[mt][j]; CIN[o] = f2bf(cacc[mt][j]); }
    } else {
#pragma unroll
        for (int mt = 0; mt < 4; ++mt)
#pragma unroll
            for (int j = 0; j < 4; ++j) a.out[O_PMLC + ((size_t)((b * 4 + h) * 128 + wave * 16 + l15)) * 256 + sl * 64 + mt * 16 + lq * 4 + j] = cacc[mt][j];
        if (sl == 0) { if (lq == 0) a.out[O_PMLN + (size_t)(b * 4 + h) * 128 + wave * 16 + l15] = cacc[4][0];
            if (tid == 0) { a.out[O_PMLM + b * 4 + h] = m_prev; ((float*)(ws + WS_GL))[b * 4 + h] = __expf(Fs + m_seg - m_prev); } }
    }
    __syncthreads();
}

__device__ __forceinline__ void sample_item(const Args& a, unsigned char* lds_, int b) {
    const int tid = threadIdx.x, lane = tid & 63, wave = tid >> 6;
    unsigned char* ws = a.ws;
    const size_t r = (size_t)NP + b;
    const bf16_t* Zr = (const bf16_t*)(ws + WS_Z) + r * ZW; const float* GATES = (const float*)(ws + WS_GATES) + r * 8;
    float* YPRE = (float*)(ws + WS_YPRE) + r * 1024; float* HPRE = (float*)(ws + WS_HPRE) + r * 1024;
    float* xr = (float*)lds_;
    float* gpre = xr + 1024;
    float* qs = gpre + 2048;
    float* ks = qs + 128;
    float* vs = ks + 128;
    float* red = vs + 256;
    float* dn = red + 2048;
#pragma unroll
    for (int i = 0; i < 2; ++i) { const int c = tid + 512 * i; const float zx = bf2f(Zr[c]);
        const float b0 = a.in[I_SRGC][((size_t)b * 3 + 0) * 1024 + c], b1 = a.in[I_SRGC][((size_t)b * 3 + 1) * 1024 + c], b2 = a.in[I_SRGC][((size_t)b * 3 + 2) * 1024 + c];
        xr[c] = a.in[I_CONVB][c] + a.in[I_CONVW][c] * b0 + a.in[I_CONVW][1024 + c] * b1 + a.in[I_CONVW][2048 + c] * b2 + a.in[I_CONVW][3072 + c] * zx;
        a.out[O_SRGC + ((size_t)b * 3 + 0) * 1024 + c] = b1; a.out[O_SRGC + ((size_t)b * 3 + 1) * 1024 + c] = b2; a.out[O_SRGC + ((size_t)b * 3 + 2) * 1024 + c] = zx; }
    __syncthreads();
    { const int mat = tid >> 8, q = tid & 255, blk = q >> 5, d4 = (q & 31) * 4;
      const float* W = (mat ? a.in[I_WRGX] : a.in[I_WRGA]) + blk * 16384 + d4; const float* xb = xr + blk * 128;
      f32x4 acc = *(const f32x4*)((mat ? a.in[I_BRGX] : a.in[I_BRGA]) + blk * 128 + d4);
#pragma unroll 1
      for (int k0 = 0; k0 < 128; k0 += 16) { f32x4 w[16];
#pragma unroll
          for (int k = 0; k < 16; ++k) w[k] = *(const f32x4*)(W + (size_t)(k0 + k) * 128);
#pragma unroll
          for (int k = 0; k < 16; ++k) acc += w[k] * xb[k0 + k]; }
      *(f32x4*)(gpre + mat * 1024 + blk * 128 + d4) = acc; }
    __syncthreads();
#pragma unroll
    for (int i = 0; i < 2; ++i) { const int c = tid + 512 * i;
        const float rg = sigmoidf_(gpre[c]), ig = sigmoidf_(gpre[1024 + c]); const float nl = -a.in[I_LAM][c]; const float sp = nl > 20.f ? nl : log1pf(__expf(nl));
        const float la = -8.f * rg * sp, av = __expf(la), mult = __builtin_amdgcn_sqrtf(fmaxf(1.f - __expf(2.f * la), 0.f));
        const float hv = av * a.in[I_SRGH][(size_t)b * 1024 + c] + mult * (ig * xr[c]);
        a.out[O_SRGH + (size_t)b * 1024 + c] = hv; YPRE[c] = hv * gelu_tanh(bf2f(Zr[1024 + c])); }
    for (int h = 0; h < 4; ++h) {
        const float* C0 = a.in[I_SMLC] + (size_t)(b * 4 + h) * 128 * 256; float* C1 = a.out + O_SMLC + (size_t)(b * 4 + h) * 128 * 256;
        f32x4 c0[16];
#pragma unroll
        for (int i = 0; i < 16; ++i) c0[i] = *(const f32x4*)(C0 + (size_t)(wave + 8 * i) * 256 + 4 * lane);
        __syncthreads();
        if (tid < 128) { qs[tid] = bf2f(Zr[2048 + h * 128 + tid]); ks[tid] = bf2f(Zr[2560 + h * 128 + tid]) * 0.08838834764831845f; }
        else if (tid < 384) vs[tid - 128] = bf2f(Zr[3072 + h * 256 + tid - 128]);
        const float li = GATES[h] + a.in[I_BMLI][h], gf = GATES[4 + h] + a.in[I_BMLF][h]; const float lf = fminf(gf, 0.f) - log1pf(__expf(-fabsf(gf)));
        const float m0 = a.in[I_SMLM][b * 4 + h]; const float m_new = fmaxf(lf + m0, li), sc = __expf(lf + m0 - m_new), Dv = __expf(li - m_new);
        __syncthreads();
        f32x4 num = {0.f, 0.f, 0.f, 0.f}; const f32x4 v4 = *(const f32x4*)(vs + 4 * lane);
#pragma unroll
        for (int i = 0; i < 16; ++i) { const int d = wave + 8 * i; const f32x4 cn = c0[i] * sc + v4 * (Dv * ks[d]);
            *(f32x4*)(C1 + (size_t)d * 256 + 4 * lane) = cn; num += cn * qs[d]; }
        *(f32x4*)(red + wave * 256 + 4 * lane) = num;
        if (tid < 128) { const float nn = sc * a.in[I_SMLN][(size_t)(b * 4 + h) * 128 + tid] + Dv * ks[tid]; a.out[O_SMLN + (size_t)(b * 4 + h) * 128 + tid] = nn; dn[tid] = nn * qs[tid]; }
        if (tid == 0) a.out[O_SMLM + b * 4 + h] = m_new;
        __syncthreads();
        if (tid < 256) { float den = 0.f;
#pragma unroll 8
            for (int k = 0; k < 128; ++k) den += dn[k];
            den = fmaxf(fabsf(den), __expf(-m_new)); float nv = 0.f;
#pragma unroll
            for (int w = 0; w < 8; ++w) nv += red[w * 256 + tid];
            HPRE[h * 256 + tid] = nv / den; }
    }
    __syncthreads();
}

__device__ __forceinline__ void fin_row(const Args& a, int r, const float* hin, int lane, bool mlnorm) {
    unsigned char* ws = a.ws; const bf16_t* Z = (const bf16_t*)(ws + WS_Z); const float* YPRE = (const float*)(ws + WS_YPRE); const float* CPRE = (const float*)(ws + WS_CPRE);
    const float* HPRE = (const float*)(ws + WS_HPRE); bf16_t* YMIX = (bf16_t*)(ws + WS_YMIX);
    f32x4 y[4]; float ss = 0.f;
#pragma unroll
    for (int j = 0; j < 4; ++j) { y[j] = *(const f32x4*)(YPRE + (size_t)r * 1024 + 4 * lane + 256 * j);
        if (hin) { const f32x4 p = *(const f32x4*)(CPRE + (size_t)r * 1024 + 4 * lane + 256 * j), hi = *(const f32x4*)(hin + 4 * lane + 256 * j);
            const u32x2 zg = *(const u32x2*)(Z + (size_t)r * ZW + 1024 + 4 * lane + 256 * j); y[j] = y[j] + p * hi;
            y[j][0] *= gelu_tanh(bflo(zg.x)); y[j][1] *= gelu_tanh(bfhi(zg.x)); y[j][2] *= gelu_tanh(bflo(zg.y)); y[j][3] *= gelu_tanh(bfhi(zg.y)); }
        ss += (y[j][0] * y[j][0] + y[j][1] * y[j][1]) + (y[j][2] * y[j][2] + y[j][3] * y[j][3]); }
    ss = wave_sum(ss); const float rs = rsqrtf(ss * (1.f / 1024.f) + EPS);
#pragma unroll
    for (int j = 0; j < 4; ++j) { const f32x4 gg = *(const f32x4*)(a.in[I_GRG] + 4 * lane + 256 * j); const f32x4 o = y[j] * rs * gg;
        u32x2 w; w.x = cvt_pk_bf16(o[0], o[1]); w.y = cvt_pk_bf16(o[2], o[3]); *(u32x2*)(YMIX + (size_t)r * DM + 4 * lane + 256 * j) = w; }
#pragma unroll
    for (int j = 0; j < 4; ++j) { f32x4 hv = *(const f32x4*)(HPRE + (size_t)r * 1024 + j * 256 + 4 * lane);
        if (mlnorm) { const f32x4 ms = *(const f32x4*)((const float*)(ws + WS_MLS) + ((size_t)r * 4 + j) * 4); hv = hv * __builtin_amdgcn_rcpf(fmaxf(fabsf(ms[0]), ms[1])); }
        const float s2 = wave_sum((hv[0] * hv[0] + hv[1] * hv[1]) + (hv[2] * hv[2] + hv[3] * hv[3])); const float r2 = rsqrtf(s2 * (1.f / 256.f) + EPS);
        const f32x4 gg = *(const f32x4*)(a.in[I_GML] + j * 256 + 4 * lane); const u32x2 zo = *(const u32x2*)(Z + (size_t)r * ZW + 4096 + j * 256 + 4 * lane);
        f32x4 o = hv * r2 * gg; o[0] *= sigmoidf_(bflo(zo.x)); o[1] *= sigmoidf_(bfhi(zo.x)); o[2] *= sigmoidf_(bflo(zo.y)); o[3] *= sigmoidf_(bfhi(zo.y));
        u32x2 w; w.x = cvt_pk_bf16(o[0], o[1]); w.y = cvt_pk_bf16(o[2], o[3]); *(u32x2*)(YMIX + (size_t)r * DM + 1024 + j * 256 + 4 * lane) = w; }
}
__device__ __forceinline__ void phase_finalize(const Args& a, unsigned char* lds_, int G) {
    const int tid = threadIdx.x, lane = tid & 63, wave = tid >> 6;
    const float* RGE = (const float*)(a.ws + WS_RGE); float* hin = (float*)lds_;
    for (int g = blockIdx.x; g < 256; g += G) {
        const int b = g >> 6, seg = (g >> 4) & 3;
        for (int c = tid; c < 1024; c += 512) { float hh = 0.f;
            for (int q = 0; q < seg; ++q) hh = RGE[((size_t)(b * 4 + q) * 2 + 0) * 1024 + c] + RGE[((size_t)(b * 4 + q) * 2 + 1) * 1024 + c] * hh;
            hin[c] = hh;
            if ((g & 63) == 63) a.out[O_PRGH + (size_t)b * 1024 + c] = RGE[((size_t)(b * 4 + 3) * 2 + 0) * 1024 + c] + RGE[((size_t)(b * 4 + 3) * 2 + 1) * 1024 + c] * hh; }
        if ((g & 63) >= 32) {
            const int hh = wave >> 1, mt = wave & 1, l15 = lane & 15, lq = lane >> 4, r0 = g * 32;
            const bf16_t* Z = (const bf16_t*)(a.ws + WS_Z); float* HPRE = (float*)(a.ws + WS_HPRE); float* MLS = (float*)(a.ws + WS_MLS);
            bf16x8 afq[4]; float gj[4];
#pragma unroll
            for (int ks = 0; ks < 4; ++ks) afq[ks] = *(const bf16x8*)(Z + (size_t)(r0 + mt * 16 + l15) * ZW + 2048 + hh * 128 + ks * 32 + lq * 8);
#pragma unroll
            for (int j = 0; j < 4; ++j) gj[j] = MLS[((size_t)(r0 + mt * 16 + lq * 4 + j) * 4 + hh) * 4 + 2];
            float* hp = HPRE + (size_t)(r0 + mt * 16 + lq * 4) * 1024 + hh * 256 + l15;
#pragma unroll 1
            for (int sl = 0; sl < 4; ++sl) { const bf16_t* cin = (const bf16_t*)(a.ws + WS_CIN) + (size_t)((b * 4 + hh) * 4 + sl) * 80 * 128;
                float old[4][4]; f32x4 acc[4];
#pragma unroll
                for (int nt = 0; nt < 4; ++nt)
#pragma unroll
                    for (int j = 0; j < 4; ++j) old[nt][j] = hp[(size_t)j * 1024 + sl * 64 + nt * 16];
#pragma unroll
                for (int nt = 0; nt < 4; ++nt) { acc[nt] = (f32x4){0.f, 0.f, 0.f, 0.f};
#pragma unroll
                    for (int ks = 0; ks < 4; ++ks) { const bf16x8 bfv = *(const bf16x8*)(cin + (nt * 16 + l15) * 128 + ks * 32 + lq * 8); acc[nt] = __builtin_amdgcn_mfma_f32_16x16x32_bf16(afq[ks], bfv, acc[nt], 0, 0, 0); } }
#pragma unroll
                for (int nt = 0; nt < 4; ++nt)
#pragma unroll
                    for (int j = 0; j < 4; ++j) hp[(size_t)j * 1024 + sl * 64 + nt * 16] = old[nt][j] + gj[j] * acc[nt][j];
                if (sl == 0) { f32x4 an = {0.f, 0.f, 0.f, 0.f};
#pragma unroll
                    for (int ks = 0; ks < 4; ++ks) { const bf16x8 bfv = *(const bf16x8*)(cin + (64 + l15) * 128 + ks * 32 + lq * 8); an = __builtin_amdgcn_mfma_f32_16x16x32_bf16(afq[ks], bfv, an, 0, 0, 0); }
                    if (l15 == 0) {
#pragma unroll
                        for (int j = 0; j < 4; ++j) MLS[((size_t)(r0 + mt * 16 + lq * 4 + j) * 4 + hh) * 4] += gj[j] * an[j]; } } }
        }
        __syncthreads();
        for (int rr = wave; rr < 32; rr += 8) fin_row(a, g * 32 + rr, hin, lane, true);
        __syncthreads();
    }
    {
        const float* CINF = (const float*)(a.ws + WS_CINF); const float* GL = (const float*)(a.ws + WS_GL);
        for (int idx = blockIdx.x * 512 + tid; idx < 16 * 128 * 256; idx += G * 512) { const int bh = idx >> 15, d = (idx >> 8) & 127, v = idx & 255;
            a.out[O_PMLC + idx] += GL[bh] * CINF[((size_t)(bh * 4 + (v >> 6)) * 80 + (v & 63)) * 128 + d]; }
        for (int idx = blockIdx.x * 512 + tid; idx < 16 * 128; idx += G * 512) { const int bh = idx >> 7, d = idx & 127;
            a.out[O_PMLN + idx] += GL[bh] * CINF[((size_t)(bh * 4) * 80 + 64) * 128 + d]; }
    }
    for (int j = blockIdx.x; j < NS; j += G) {
        if (wave == 0) fin_row(a, NP + j, nullptr, lane, false);
        if (wave == 1) {
#pragma unroll
            for (int q = 0; q < 8; ++q) *(u32x2*)((bf16_t*)(a.ws + WS_YMIX) + (size_t)(MV + j) * DM + 4 * lane + 256 * q) = (u32x2){0u, 0u}; }
    }
}

__device__ __forceinline__ void sattn_item(const Args& a, unsigned char* lds_, int b, int h) {
    const int tid = threadIdx.x, lane = tid & 63, wave = tid >> 6;
    unsigned char* ws = a.ws;
    float* SC = (float*)lds_;
    float* RED = SC + 1024;
    float q[8];
    { f32x4 q0 = {0.f, 0.f, 0.f, 0.f}, q1 = {0.f, 0.f, 0.f, 0.f}; const float* qp = (const float*)(ws + WS_P4) + (size_t)b * DM + h * 512 + lane * 8;
#pragma unroll
      for (int k = 0; k < 8; ++k) { q0 += *(const f32x4*)(qp + (size_t)k * NS * DM); q1 += *(const f32x4*)(qp + (size_t)k * NS * DM + 4); }
#pragma unroll
      for (int e = 0; e < 4; ++e) { q[e] = q0[e] * 0.04419417382415922f; q[4 + e] = q1[e] * 0.04419417382415922f; } }
    const float* kb = a.in[I_CK] + ((size_t)b * NMEM * 4 + h) * 512 + lane * 8; const float* vb = a.in[I_CV] + ((size_t)b * NMEM * 4 + h) * 512 + lane * 8;
    float mys = 0.f;
#pragma unroll 8
    for (int mm = 0; mm < 32; ++mm) { const float* p = kb + (size_t)(wave * 32 + mm) * DM; const f32x4 k0 = __builtin_nontemporal_load((const f32x4*)p), k1 = __builtin_nontemporal_load((const f32x4*)(p + 4));
        float d = (k0[0] * q[0] + k0[1] * q[1]) + (k0[2] * q[2] + k0[3] * q[3]) + (k1[0] * q[4] + k1[1] * q[5]) + (k1[2] * q[6] + k1[3] * q[7]);
        d = wave_sum(d); if (lane == mm) mys = d; }
    if (lane < 32) SC[wave * 32 + lane] = mys;
    __syncthreads();
    const float s0 = SC[lane], s1 = SC[64 + lane], s2 = SC[128 + lane], s3 = SC[192 + lane];
    const float mx = wave_max(fmaxf(fmaxf(s0, s1), fmaxf(s2, s3)));
    const float tot = wave_sum((__expf(s0 - mx) + __expf(s1 - mx)) + (__expf(s2 - mx) + __expf(s3 - mx)));
    f32x4 o0 = {0.f, 0.f, 0.f, 0.f}, o1 = {0.f, 0.f, 0.f, 0.f};
#pragma unroll 8
    for (int mm = 0; mm < 32; ++mm) { const int m = wave * 32 + mm; const float* p = vb + (size_t)m * DM; const float pr = __expf(SC[m] - mx);
        o0 += pr * __builtin_nontemporal_load((const f32x4*)p); o1 += pr * __builtin_nontemporal_load((const f32x4*)(p + 4)); }
    *(f32x4*)(RED + wave * 512 + lane * 8) = o0; *(f32x4*)(RED + wave * 512 + lane * 8 + 4) = o1;
    __syncthreads();
    { float s = 0.f;
#pragma unroll
      for (int w = 0; w < 8; ++w) s += RED[w * 512 + tid];
      ((bf16_t*)(ws + WS_OB))[((size_t)NP + b) * DM + h * 512 + tid] = f2bf(s / tot); }
    __syncthreads();
}

__device__ __forceinline__ void sample_prep(const float* X, const float* Pp, int nks, const float* g, bf16_t* Aout, float* Xnext, int lane) {
    f32x4 v[8]; float ss = 0.f;
#pragma unroll
    for (int j = 0; j < 8; ++j) { v[j] = *(const f32x4*)(X + 4 * lane + 256 * j);
        for (int k = 0; k < nks; ++k) v[j] += *(const f32x4*)(Pp + (size_t)k * NS * DM + 4 * lane + 256 * j);
        ss += (v[j][0] * v[j][0] + v[j][1] * v[j][1]) + (v[j][2] * v[j][2] + v[j][3] * v[j][3]); }
    ss = wave_sum(ss); const float rs = rsqrtf(ss * (1.f / DM) + EPS);
#pragma unroll
    for (int j = 0; j < 8; ++j) { *(f32x4*)(Xnext + 4 * lane + 256 * j) = v[j]; const f32x4 o = v[j] * rs * *(const f32x4*)(g + 4 * lane + 256 * j);
        u32x2 w; w.x = cvt_pk_bf16(o[0], o[1]); w.y = cvt_pk_bf16(o[2], o[3]); *(u32x2*)(Aout + 4 * lane + 256 * j) = w; }
}
__device__ __forceinline__ void phase_final(const Args& a, int G, bool prompt_done) {
    if (prompt_done) {
        extern __shared__ __attribute__((aligned(16))) unsigned char lds_dyn_[]; float* red8 = (float*)lds_dyn_;
        const int tid_ = threadIdx.x, lane_ = tid_ & 63, wave_ = tid_ >> 6;
        for (int rs_ = blockIdx.x; rs_ < NS; rs_ += G) {
            const float* src = (const float*)(a.ws + WS_X2S) + (size_t)rs_ * DM + wave_ * 256 + 4 * lane_; const float* pp = (const float*)(a.ws + WS_P8) + (size_t)rs_ * DM + wave_ * 256 + 4 * lane_;
            f32x4 v = *(const f32x4*)src; f32x4 p[22];
#pragma unroll
            for (int k = 0; k < 22; ++k) p[k] = *(const f32x4*)(pp + (size_t)k * NS * DM);
#pragma unroll
            for (int k = 0; k < 22; ++k) v += p[k];
            const float ss = wave_sum((v[0] * v[0] + v[1] * v[1]) + (v[2] * v[2] + v[3] * v[3]));
            __syncthreads();
            if (lane_ == 0) red8[wave_] = ss;
            __syncthreads();
            const float tot = ((red8[0] + red8[1]) + (red8[2] + red8[3])) + ((red8[4] + red8[5]) + (red8[6] + red8[7]));
            const float rs = rsqrtf(tot * (1.f / DM) + EPS);
            *(f32x4*)(a.out + O_YS + (size_t)rs_ * DM + wave_ * 256 + 4 * lane_) = v * rs * *(const f32x4*)(a.in[I_GFIN] + wave_ * 256 + 4 * lane_);
        }
        return;
    }
    const int lane = threadIdx.x & 63, wave = threadIdx.x >> 6; const int gw = blockIdx.x * 8 + wave, NGW = G * 8;
    for (int r = prompt_done ? NP + gw : gw; r < MV; r += NGW) { float* p = r < NP ? a.out + O_YP + (size_t)r * DM : a.out + O_YS + (size_t)(r - NP) * DM;
        const float* src = r < NP ? p : (const float*)(a.ws + WS_X2S) + (size_t)(r - NP) * DM;
        f32x4 v[8]; float ss = 0.f;
#pragma unroll
        for (int j = 0; j < 8; ++j) { v[j] = *(const f32x4*)(src + 4 * lane + 256 * j);
            if (r >= NP) { for (int k = 0; k < 22; ++k) v[j] += *(const f32x4*)((const float*)(a.ws + WS_P8) + ((size_t)k * NS + (r - NP)) * DM + 4 * lane + 256 * j); } ss += (v[j][0] * v[j][0] + v[j][1] * v[j][1]) + (v[j][2] * v[j][2] + v[j][3] * v[j][3]); }
        ss = wave_sum(ss); const float rs = rsqrtf(ss * (1.f / DM) + EPS);
#pragma unroll
        for (int j = 0; j < 8; ++j) *(f32x4*)(p + 4 * lane + 256 * j) = v[j] * rs * *(const f32x4*)(a.in[I_GFIN] + 4 * lane + 256 * j); }
}

#define XB_TMO      128
#define XB_XCNT(j)  (256  + 64 * (j))
#define XB_XSUB(j)  (1280 + 64 * (j))
#define XB_XGEN(j)  (2304 + 64 * (j))
#define XB_TOP      3328
#define XB_TOPGEN   3392
#define XCD_BAR_WORDS 3456
#define XB_SPIN_CAP (1u << 18)
__device__ __forceinline__ unsigned xb_ld(unsigned* p)              { return __hip_atomic_load(p, __ATOMIC_RELAXED, __HIP_MEMORY_SCOPE_AGENT); }
__device__ __forceinline__ unsigned xb_add(unsigned* p, unsigned v) { return __hip_atomic_fetch_add(p, v, __ATOMIC_RELAXED, __HIP_MEMORY_SCOPE_AGENT); }
__device__ __forceinline__ unsigned xb_xcc_id() { return (unsigned)__builtin_amdgcn_s_getreg((3 << 11) | 20) & 0xFu; }
#define XB_SPIN(cond, bar) do { unsigned _sp = 0; while (cond) { __builtin_amdgcn_s_sleep(1); \
    if ((++_sp & 255u) == 0u) { if (xb_ld(&(bar)[XB_TMO])) break; if (_sp > XB_SPIN_CAP) { atomicAdd(&(bar)[XB_TMO], 1u); break; } } } } while (0)
struct XcdBarrier { unsigned* bar; unsigned x; volatile LAS unsigned* st; };
__device__ __forceinline__ void xcd_barrier_complete(unsigned* bar, unsigned x, unsigned& nloc, unsigned& nx) {
    const unsigned G = gridDim.x * gridDim.y * gridDim.z;
    unsigned sum, cnt, mine, sp = 0u;
    for (;;) {
        sum = 0u; cnt = 0u; mine = 0u;
#pragma unroll
        for (unsigned j = 0; j < 16; ++j) { const unsigned c = xb_ld(&bar[XB_XCNT(j)]); sum += c; cnt += (c > 0u) ? 1u : 0u; mine = (j == x) ? c : mine; }
        if (sum == G) break;
        __builtin_amdgcn_s_sleep(1);
        if ((++sp & 255u) == 0u) { if (xb_ld(&bar[XB_TMO])) break; if (sp > XB_SPIN_CAP) { atomicAdd(&bar[XB_TMO], 1u); break; } }
    }
    nloc = mine > 0u ? mine : 1u; nx = cnt > 0u ? cnt : 1u;
}
__device__ __forceinline__ void xcd_barrier(const XcdBarrier& b) {
    asm volatile("s_waitcnt vmcnt(0)" ::: "memory");
    __syncthreads();
    if (threadIdx.x == 0) {
        unsigned* bar = b.bar;
        __builtin_amdgcn_s_waitcnt(0);
        unsigned nloc = b.st[0], nx = b.st[1];
        if (nloc == 0u) { xcd_barrier_complete(bar, b.x, nloc, nx); b.st[0] = nloc; b.st[1] = nx; }
        const unsigned old = xb_add(&bar[XB_XSUB(b.x)], 1u);
        const unsigned gen = old / nloc;
        if (old + 1u == (gen + 1u) * nloc) {
            __builtin_amdgcn_fence(__ATOMIC_RELEASE, "agent");
            asm volatile("s_waitcnt vmcnt(0)" ::: "memory");
            const unsigned og = xb_add(&bar[XB_TOP], 1u);
            const unsigned tg = og / nx;
            if (og + 1u == (tg + 1u) * nx) xb_add(&bar[XB_TOPGEN], 1u);
            else XB_SPIN(xb_ld(&bar[XB_TOPGEN]) == tg, bar);
            __builtin_amdgcn_fence(__ATOMIC_ACQUIRE, "agent");
            xb_add(&bar[XB_XGEN(b.x)], 1u);
            asm volatile("s_waitcnt vmcnt(0)" ::: "memory");
        } else {
            XB_SPIN(xb_ld(&bar[XB_XGEN(b.x)]) == gen, bar);
            __builtin_amdgcn_fence(__ATOMIC_ACQUIRE, "agent");
            asm volatile("s_waitcnt vmcnt(0)" ::: "memory");
        }
    }
    __syncthreads();
}

__global__ void __launch_bounds__(512, 2) mk_fwd(Args a) {
    extern __shared__ __attribute__((aligned(16))) unsigned char lds[];
    cg::grid_group grid = cg::this_grid();
    LAS unsigned char* ring = (LAS unsigned char*)lds;
    const int G = gridDim.x, bx = blockIdx.x;
    unsigned char* ws = a.ws;
    const int lo = a.ph_lo, hi = a.ph_hi;
#define IN(k) (lo <= (k) && (k) < hi)
    XcdBarrier xbar; xbar.bar = (unsigned*)ws; xbar.x = xb_xcc_id(); xbar.st = (volatile LAS unsigned*)(ring + (LDS_BYTES - 64));
    if (threadIdx.x == 0) { xbar.st[0] = 0u; xbar.st[1] = 0u; if (hi - lo > 1) (void)xb_add(&xbar.bar[XB_XCNT(xbar.x)], 1u); }
    __syncthreads();
    if (hi > 4096) grid.sync();
#define SEAM(k) do { if (IN(k) && IN((k) + 1)) xcd_barrier(xbar); } while (0)
    const bf16_t* ABUF = (const bf16_t*)(ws + WS_ABUF);

    if (IN(0)) { phase_prologue(a, lds, G); }
    SEAM(0);
    if (IN(1)) {
        { pg8::SchedStd S; S.init(ws + WS_MN, ws + WS_WKV, DM, DM, 1024, 4096, G, bx);
          pg8::EpiKV E{a.out + O_PMK, a.out + O_PMV, (bf16_t*)(ws + WS_KB), (bf16_t*)(ws + WS_VT)};
          pg8::gemm_phase<pg8::EpiKV, pg8::SchedStd, true>(ring, DM, DM, DM, S, E); }
        { const int nwg1 = 4 * 16; pg8::SchedStd S; S.init(ABUF, ws + WS_WIN, DM, DM, MA, ZW, G, (bx + G - (nwg1 % G)) % G); pg8::EpiBf16 E{(bf16_t*)(ws + WS_Z), ZW};
          pg8::gemm_phase<pg8::EpiBf16, pg8::SchedStd, true>(ring, DM, DM, DM, S, E); }
        if (G == 256 && bx >= 212) { __syncthreads(); late_transposes(a, lds, 0, 32 * 88, (bx - 212) * 8 + (threadIdx.x >> 6), 352); }
    }
    SEAM(1);
    if (IN(2)) {
        for (int it = bx; it < 128; it += G) rg_item(a, lds, it >> 5, it & 7, (it >> 3) & 3);
        __syncthreads();
        for (int j = (bx + G - (128 % G)) % G; j < 128; j += G) ml_item(a, lds, j >> 5, (j >> 3) & 3, (j >> 1) & 3, j & 1);
        __syncthreads();
        for (int j = bx; j < NS; j += G) sample_item(a, lds, j);
        __syncthreads();
        if (G == 256) late_transposes(a, lds, 3 * 32 * 88, LATE_ITEMS, bx * 8 + (threadIdx.x >> 6), 2048);
        else late_transposes(a, lds, 0, LATE_ITEMS, bx * 8 + (threadIdx.x >> 6), G * 8);
    }
    SEAM(2);
    if (IN(3)) { phase_finalize(a, lds, G); }
    SEAM(3);
    if (IN(4)) {
        { pg8::SchedStd S; S.init(ws + WS_YMIX, ws + WS_WOUT, DM, DM, NP, DM, G, bx);
          pg8::EpiRes<1> E{a.in[I_XP], a.in[I_XS], (float*)(ws + WS_X1), nullptr, nullptr, a.in[I_GXA], (bf16_t*)(ws + WS_ABUF), (float*)(ws + WS_SSQ1)};
          pg8::gemm_phase<pg8::EpiRes<1>, pg8::SchedStd, true>(ring, DM, DM, DM, S, E); }
        { pg8::SchedSK S{(const char*)(ws + WS_YMIX) + (size_t)NP * DM * 2, (const char*)(ws + WS_WOUT), DM, 8, 8, G, bx}; pg8::EpiPartial E{(float*)(ws + WS_P3), DM};
          pg8::gemm_phase<pg8::EpiPartial, pg8::SchedSK, true>(ring, DM, DM, 256, S, E); }
    }
    SEAM(4);
    if (IN(5)) {
        { const int gw = bx * 8 + (threadIdx.x >> 6); if (gw < NS) sample_prep(a.in[I_XS] + (size_t)gw * DM, (const float*)(ws + WS_P3) + (size_t)gw * DM, 8, a.in[I_GXA], (bf16_t*)(ws + WS_ABUF) + (size_t)(NP + gw) * DM, (float*)(ws + WS_X1S) + (size_t)gw * DM, threadIdx.x & 63); }
        pg8::SchedStd S; S.init(ABUF, ws + WS_WQ, DM, DM, NP, DM, G, bx);
        pg8::EpiQ E{(const float*)(ws + WS_SSQ1), (bf16_t*)(ws + WS_QB), 0.04419417382415922f};
        pg8::gemm_phase<pg8::EpiQ, pg8::SchedStd, true>(ring, DM, DM, DM, S, E);
    }
    SEAM(5);
    if (IN(6)) {
        if (G >= 128) { pg8::SchedS S{(const char*)(ws + WS_QB), (const char*)(ws + WS_KB), G, bx}; pg8::EpiSoftmax E{(bf16_t*)(ws + WS_P)};
            pg8::gemm_phase<pg8::EpiSoftmax, pg8::SchedS, false>(ring, DM, DM, 512, S, E); }
        __syncthreads();
        { pg8::SchedSK S{(const char*)(ws + WS_ABUF) + (size_t)NP * DM * 2, (const char*)(ws + WS_WQ), DM, 8, 8, G, (bx + G - (128 % G)) % G}; pg8::EpiPartial E{(float*)(ws + WS_P4), DM};
          pg8::gemm_phase<pg8::EpiPartial, pg8::SchedSK, true>(ring, DM, DM, 256, S, E); }
        if (G == 256 && bx >= 192) { __syncthreads(); late_transposes(a, lds, 32 * 88, 2 * 32 * 88, (bx - 192) * 8 + (threadIdx.x >> 6), 512); }
    }
    SEAM(6);
    if (IN(7)) {
        { pg8::SchedPV S{(const char*)(ws + WS_P), (const char*)(ws + WS_VT), G, bx}; pg8::EpiBf16 E{(bf16_t*)(ws + WS_OB), DM};
          pg8::gemm_phase<pg8::EpiBf16, pg8::SchedPV, true>(ring, 256, 256, 256, S, E); }
        __syncthreads();
        for (int it = bx; it < NS * 4; it += G) sattn_item(a, lds, it >> 2, it & 3);
    }
    SEAM(7);
    if (IN(8)) {
        { pg8::SchedStd S; S.init(ws + WS_OB, ws + WS_WO, DM, DM, NP, DM, G, bx);
          pg8::EpiRes<2> E{nullptr, nullptr, (float*)(ws + WS_X1), nullptr, nullptr, a.in[I_GFFN], (bf16_t*)(ws + WS_ABUF), (float*)(ws + WS_SSQ2)};
          pg8::gemm_phase<pg8::EpiRes<2>, pg8::SchedStd, true>(ring, DM, DM, DM, S, E); }
        { pg8::SchedSK S{(const char*)(ws + WS_OB) + (size_t)NP * DM * 2, (const char*)(ws + WS_WO), DM, 8, 8, G, bx}; pg8::EpiPartial E{(float*)(ws + WS_P6), DM};
          pg8::gemm_phase<pg8::EpiPartial, pg8::SchedSK, true>(ring, DM, DM, 256, S, E); }
    }
    SEAM(8);
    if (IN(9)) {
        const int gw = bx * 8 + (threadIdx.x >> 6); if (gw < NS) sample_prep((const float*)(ws + WS_X1S) + (size_t)gw * DM, (const float*)(ws + WS_P6) + (size_t)gw * DM, 8, a.in[I_GFFN], (bf16_t*)(ws + WS_ABUF) + (size_t)(NP + gw) * DM, (float*)(ws + WS_X2S) + (size_t)gw * DM, threadIdx.x & 63);
    }
    SEAM(9);
    if (IN(10)) {
        { pg8::SchedStd S; S.init(ABUF, ws + WS_WGU, DM, DM, NP, 2 * DFF, G, bx);
          pg8::EpiGU E{(const float*)(ws + WS_SSQ2), (bf16_t*)(ws + WS_H)};
          pg8::gemm_phase<pg8::EpiGU, pg8::SchedStd, true>(ring, DM, DM, DM, S, E); }
        { const int nwg1 = (NP / 256) * (2 * DFF / 256); pg8::SchedStd S; S.init(ABUF + (size_t)NP * DM, ws + WS_WGU, DM, DM, 256, 2 * DFF, G, (bx + G - (nwg1 % G)) % G);
          pg8::EpiGU E{nullptr, (bf16_t*)(ws + WS_H) + (size_t)NP * DFF};
          pg8::gemm_phase<pg8::EpiGU, pg8::SchedStd, true>(ring, DM, DM, DM, S, E); }
        if (G == 256 && bx >= 172) { __syncthreads(); late_transposes(a, lds, 2 * 32 * 88, 3 * 32 * 88, (bx - 172) * 8 + (threadIdx.x >> 6), 672); }
    }
    SEAM(10);
    if (IN(11)) {
        if (G == 256) { pg8::SchedStd S; S.init(ws + WS_H, ws + WS_WD, DFF, DFF, NP, DM, G, bx);
          pg8::EpiFinal E{(const float*)(ws + WS_X1), a.out + O_YP, a.in[I_GFIN], (float*)(ws + WS_SLOTS), (unsigned*)ws + 4096};
          pg8::gemm_phase<pg8::EpiFinal, pg8::SchedStd, false>(ring, DFF, DFF, DFF, S, E); }
        else { pg8::SchedStd S; S.init(ws + WS_H, ws + WS_WD, DFF, DFF, NP, DM, G, bx);
          pg8::EpiRes<3> E{nullptr, nullptr, (float*)(ws + WS_X1), a.out + O_YP, a.out + O_YS, nullptr, nullptr, nullptr};
          pg8::gemm_phase<pg8::EpiRes<3>, pg8::SchedStd, true>(ring, DFF, DFF, DFF, S, E); }
        { pg8::SchedSK S{(const char*)(ws + WS_H) + (size_t)NP * DFF * 2, (const char*)(ws + WS_WD), DFF, 8, 22, G, bx}; pg8::EpiPartial E{(float*)(ws + WS_P8), DM};
          pg8::gemm_phase<pg8::EpiPartial, pg8::SchedSK, true>(ring, DFF, DFF, 256, S, E); }
    }
    SEAM(11);
    if (IN(12)) { phase_final(a, G, G == 256); }
#undef IN
#undef SEAM
}

extern "C" void kernel_launch(void* const* d_in, const int* in_sizes, int n_in, void* d_out, int out_size, void* d_ws, size_t ws_size, hipStream_t stream) {
    static int grid = 0;
    if (grid == 0) {
        if (n_in != 35 || (size_t)out_size != O_END || ws_size < WS_END) { fprintf(stderr, "kernel_launch: unexpected sizes n_in %d out %d ws %zu\n", n_in, out_size, ws_size); grid = -1; return; }
        int dev = 0, cus = 0, per_cu = 0;
        (void)hipGetDevice(&dev); (void)hipDeviceGetAttribute(&cus, hipDeviceAttributeMultiprocessorCount, dev);
        if (hipFuncSetAttribute((const void*)mk_fwd, hipFuncAttributeMaxDynamicSharedMemorySize, LDS_BYTES) != hipSuccess) { fprintf(stderr, "kernel_launch: hipFuncSetAttribute failed\n"); grid = -1; return; }
        if (hipOccupancyMaxActiveBlocksPerMultiprocessor(&per_cu, (const void*)mk_fwd, 512, LDS_BYTES) != hipSuccess || per_cu < 1) { fprintf(stderr, "kernel_launch: occupancy query says %d\n", per_cu); per_cu = 1; }
        (void)hipGetLastError();
        grid = cus * 1;
        if (grid < 128) fprintf(stderr, "kernel_launch: grid %d < 128\n", grid);
    }
    if (grid < 0) return;
    Args a{};
    for (int i = 0; i < 35; ++i) a.in[i] = (const float*)d_in[i];
    a.out = (float*)d_out; a.ws = (unsigned char*)d_ws;
    constexpr int NL = MK_N_LAUNCHES;
    if (hipMemsetAsync(d_ws, 0, 32768, stream) != hipSuccess) { fprintf(stderr, "kernel_launch: memset of the barrier word failed\n"); return; }
    for (int li = 0; li < NL; ++li) {
        a.ph_lo = (NL == 1) ? 0 : li; a.ph_hi = (NL == 1) ? N_PHASES : li + 1;
        void* args[] = {&a};
        hipError_t e = hipLaunchCooperativeKernel((const void*)mk_fwd, dim3(grid), dim3(512), args, LDS_BYTES, stream);
        if (e != hipSuccess) { fprintf(stderr, "kernel_launch: cooperative launch %d failed: %s (grid %d)\n", li, hipGetErrorString(e), grid); break; }
    }
}
```

```cpp
#include <hip/hip_runtime.h>
#include <hip/hip_cooperative_groups.h>
#include <cstdio>
#include <cstdint>
namespace cg = cooperative_groups;

#ifndef MK_N_LAUNCHES
#define MK_N_LAUNCHES 1
#endif

#define LAS __attribute__((address_space(3)))
typedef unsigned short bf16_t;
typedef short bf16x8 __attribute__((ext_vector_type(8)));
typedef float f32x4 __attribute__((ext_vector_type(4)));
typedef unsigned u32x4 __attribute__((ext_vector_type(4)));
typedef unsigned u32x2 __attribute__((ext_vector_type(2)));

constexpr int DM = 2048, NP = 8192, NS = 128, MV = NP + NS, MA = 8448, ZW = 5120, INW = 5128, DFF = 5632, SEQ = 2048, NMEM = 256;
constexpr float EPS = 1e-6f;
constexpr int N_PHASES = 13;

constexpr size_t O_YP = 0, O_YS = O_YP + (size_t)NP * DM, O_PRGH = O_YS + (size_t)NS * DM, O_PRGC = O_PRGH + 4096, O_PMLC = O_PRGC + 12288,
                 O_PMLN = O_PMLC + 524288, O_PMLM = O_PMLN + 2048, O_PMK = O_PMLM + 16, O_PMV = O_PMK + 2097152, O_SRGH = O_PMV + 2097152,
                 O_SRGC = O_SRGH + 131072, O_SMLC = O_SRGC + 393216, O_SMLN = O_SMLC + 16777216, O_SMLM = O_SMLN + 65536, O_END = O_SMLM + 512;

constexpr size_t MiB = 1u << 20;
constexpr size_t WS_WIN = 1 * MiB, WS_WOUT = 21 * MiB, WS_WQ = 29 * MiB, WS_WKV = 37 * MiB, WS_WO = 53 * MiB, WS_WGU = 61 * MiB, WS_WD = 105 * MiB,
                 WS_WRG = 127 * MiB, WS_ABUF = 128 * MiB, WS_MN = 161 * MiB, WS_Z = 165 * MiB, WS_GATES = 248 * MiB, WS_YPRE = 249 * MiB,
                 WS_HPRE = 282 * MiB, WS_YMIX = 315 * MiB, WS_X1 = 348 * MiB, WS_SSQ1 = 414 * MiB, WS_SSQ2 = 416 * MiB, WS_QB = 418 * MiB,
                 WS_OB = 451 * MiB, WS_KB = 484 * MiB, WS_VT = 488 * MiB, WS_P = 492 * MiB, WS_H = 508 * MiB, WS_X1S = 600 * MiB, WS_X2S = 601 * MiB, WS_P3 = 604 * MiB, WS_P4 = 612 * MiB, WS_P6 = 620 * MiB, WS_P8 = 628 * MiB, WS_CPRE = 652 * MiB, WS_RGE = 685 * MiB, WS_MLS = 686 * MiB, WS_CIN = 687 * MiB, WS_CINF = 689 * MiB, WS_GL = 692 * MiB, WS_SLOTS = 693 * MiB, WS_END = 694 * MiB;

constexpr int LDS_BYTES = 147456;

__device__ __forceinline__ unsigned cvt_pk_bf16(float lo, float hi) { unsigned r; asm("v_cvt_pk_bf16_f32 %0, %1, %2" : "=v"(r) : "v"(lo), "v"(hi)); return r; }
__device__ __forceinline__ float bf2f(unsigned short b) { return __uint_as_float((unsigned)b << 16); }
__device__ __forceinline__ bf16_t f2bf(float f) { return (bf16_t)(cvt_pk_bf16(f, 0.f) & 0xffffu); }
__device__ __forceinline__ float bflo(unsigned w) { return __uint_as_float(w << 16); }
__device__ __forceinline__ float bfhi(unsigned w) { return __uint_as_float(w & 0xffff0000u); }
__device__ __forceinline__ float wave_sum(float v) {
#pragma unroll
    for (int o = 1; o < 64; o <<= 1) v += __shfl_xor(v, o);
    return v;
}
__device__ __forceinline__ float wave_max(float v) {
#pragma unroll
    for (int o = 1; o < 64; o <<= 1) v = fmaxf(v, __shfl_xor(v, o));
    return v;
}
__device__ __forceinline__ float sigmoidf_(float x) { return __builtin_amdgcn_rcpf(1.f + __expf(-x)); }
__device__ __forceinline__ float gelu_tanh(float x) { const float u2 = 1.5957691216057308f * (x + 0.044715f * x * x * x); return x * sigmoidf_(u2); }
#define LDS_WAIT() asm volatile("s_waitcnt lgkmcnt(0)" ::: "memory")
#define LBAR() do { asm volatile("s_waitcnt lgkmcnt(0)" ::: "memory"); __builtin_amdgcn_s_barrier(); asm volatile("" ::: "memory"); } while (0)

namespace pg8 {
constexpr int BM = 256, BK = 64, HALF = 128, HTB = HALF * BK * 2, STAGE_BYTES = 8 * HTB, NXCD = 8, WGM = 8;
__host__ __device__ __forceinline__ int lds_byte(int r, int c) { const int st = (r >> 4) * 2 + (c >> 5), rr = r & 15, cc = c & 31, ob = rr * 64 + cc * 2; return st * 1024 + (ob ^ (((ob >> 9) & 1) << 5)); }
__host__ __device__ __forceinline__ void stage_rc(int b, int& R, int& C) { const int st = b / 1024, sb = b % 1024, swz = sb ^ (((sb >> 9) & 1) << 5); R = (st >> 1) * 16 + swz / 64; C = (st & 1) * 32 + (swz % 64) / 2; }
__host__ __device__ __forceinline__ int perm32(int rho) { const int n = rho >> 4, i = rho & 15; return 8 * (i >> 2) + 4 * n + (i & 3); }

struct Unit { int pm, pn; };

struct SchedStd {
    const char* A; const char* B; size_t sA, sB; int nM, nN, nwg, G, c;
    __device__ void init(const void* A_, const void* B_, int lda, int ldb, int M, int N, int G_, int c_) {
        A = (const char*)A_; B = (const char*)B_; sA = (size_t)BM * lda * 2; sB = (size_t)BM * ldb * 2; nM = M / BM; nN = N / BM; nwg = nM * nN; G = G_; c = c_; }
    __device__ bool next(int i, Unit& u) const {
        const long L = (long)i * G + c; if (L >= nwg) return false;
        int wgid = (int)L; { const int q = nwg / NXCD, r = nwg % NXCD, xcd = wgid % NXCD, off = wgid / NXCD; wgid = (xcd < r ? xcd * (q + 1) : r * (q + 1) + (xcd - r) * q) + off; }
        const int nig = WGM * nN, gid = wgid / nig, fm = gid * WGM, gsz = (nM - fm) < WGM ? (nM - fm) : WGM;
        u.pm = fm + ((wgid % nig) % gsz); u.pn = (wgid % nig) / gsz; return true;
    }
    __device__ __forceinline__ const char* aptr(const Unit& u) const { return A + (size_t)u.pm * sA; }
    __device__ __forceinline__ const char* bptr(const Unit& u) const { return B + (size_t)u.pn * sB; }
};
struct SchedS {
    const char* Q; const char* Kb; int G, c;
    __device__ bool next(int i, Unit& u) const { const int L = i * G + c; if (L >= 128) return false; const int b = L >> 5, h = (L >> 3) & 3, qt = L & 7; u.pm = b * 8 + qt; u.pn = h; return true; }
    __device__ __forceinline__ const char* aptr(const Unit& u) const { return Q + ((size_t)u.pm * 256 * DM + (size_t)u.pn * 512) * 2; }
    __device__ __forceinline__ const char* bptr(const Unit& u) const { return Kb + ((size_t)(u.pm >> 3) * 256 * DM + (size_t)u.pn * 512) * 2; }
};
struct SchedPV {
    const char* P; const char* VT; int G, c;
    __device__ bool next(int i, Unit& u) const { const int L = i * G + c; if (L >= 256) return false; const int bh = L >> 4, qt = (L >> 1) & 7, nh = L & 1; u.pm = (bh >> 2) * 8 + qt; u.pn = (bh & 3) * 2 + nh; return true; }
    __device__ __forceinline__ const char* aptr(const Unit& u) const { const int bh = (u.pm >> 3) * 4 + (u.pn >> 1); return P + ((size_t)bh * 2048 + (size_t)(u.pm & 7) * 256) * 256 * 2; }
    __device__ __forceinline__ const char* bptr(const Unit& u) const { const int bh = (u.pm >> 3) * 4 + (u.pn >> 1); return VT + ((size_t)bh * 512 + (size_t)(u.pn & 1) * 256) * 256 * 2; }
};

typedef f32x4 Acc[2][2][4][2];
__device__ __forceinline__ u32x4 pack8(const f32x4 v0, const f32x4 v1) { u32x4 w; w.x = cvt_pk_bf16(v0[0], v0[1]); w.y = cvt_pk_bf16(v0[2], v0[3]); w.z = cvt_pk_bf16(v1[0], v1[1]); w.w = cvt_pk_bf16(v1[2], v1[3]); return w; }

struct EpiBf16 {
    static constexpr bool PERM = true, AFTER_DRAIN = false;
    bf16_t* O; int ldc;
    __device__ __forceinline__ void operator()(const Acc& acc, const Unit& u, int wr, int wc, int fr, int fq) const {
        const int row0 = u.pm * BM + wr * 64 + fr, col0 = u.pn * BM + wc * 32 + 8 * fq;
#pragma unroll
        for (int ai = 0; ai < 2; ++ai)
#pragma unroll
            for (int m = 0; m < 4; ++m) { bf16_t* rowp = O + (size_t)(row0 + ai * HALF + m * 16) * ldc + col0;
#pragma unroll
                for (int bj = 0; bj < 2; ++bj) *(u32x4*)(rowp + bj * HALF) = pack8(acc[ai][bj][m][0], acc[ai][bj][m][1]); }
    }
};
struct EpiKV {
    static constexpr bool PERM = true, AFTER_DRAIN = false;
    float* outK; float* outV; bf16_t* KB; bf16_t* VT;
    __device__ __forceinline__ void operator()(const Acc& acc, const Unit& u, int wr, int wc, int fr, int fq) const {
        const int row0 = u.pm * BM + wr * 64 + fr, col0 = (u.pn & 7) * BM + wc * 32 + 8 * fq; const bool isV = u.pn >= 8;
#pragma unroll
        for (int ai = 0; ai < 2; ++ai)
#pragma unroll
            for (int m = 0; m < 4; ++m) { const int r = row0 + ai * HALF + m * 16;
#pragma unroll
                for (int bj = 0; bj < 2; ++bj) { const int c = col0 + bj * HALF; const f32x4 v0 = acc[ai][bj][m][0], v1 = acc[ai][bj][m][1];
                    float* o = (isV ? outV : outK) + (size_t)r * DM + c; *(f32x4*)o = v0; *(f32x4*)(o + 4) = v1;
                    if (!isV) *(u32x4*)(KB + (size_t)r * DM + c) = pack8(v0, v1);
                    else { const int b = r >> 8, mm = r & 255, h = c >> 9, d = c & 511; bf16_t* base = VT + ((size_t)((b * 4 + h) * 512 + d)) * 256 + mm;
#pragma unroll
                        for (int e = 0; e < 4; ++e) { base[(size_t)e * 256] = f2bf(v0[e]); base[(size_t)(4 + e) * 256] = f2bf(v1[e]); } } } }
    }
};
template <int MODE> struct EpiRes {
    static constexpr bool PERM = true, AFTER_DRAIN = false;
    const float* xp; const float* xs; float* X1; float* yp; float* ys; const float* g; bf16_t* Aout; float* SSQ;
    __device__ __forceinline__ void operator()(const Acc& acc, const Unit& u, int wr, int wc, int fr, int fq) const {
        const int row0 = u.pm * BM + wr * 64 + fr, col0 = u.pn * BM + wc * 32 + 8 * fq;
        f32x4 gv[2][2];
        if (MODE != 3) {
#pragma unroll
            for (int bj = 0; bj < 2; ++bj)
#pragma unroll
                for (int n = 0; n < 2; ++n) gv[bj][n] = *(const f32x4*)(g + col0 + bj * HALF + 4 * n); }
#pragma unroll
        for (int ai = 0; ai < 2; ++ai)
#pragma unroll
            for (int m = 0; m < 4; ++m) { const int r = row0 + ai * HALF + m * 16;
                const float* src; float* dst;
                if (MODE == 1) { const int rc = r < MV ? r : MV - 1; src = rc < NP ? xp + (size_t)rc * DM : xs + (size_t)(rc - NP) * DM; dst = X1 + (size_t)r * DM; }
                else if (MODE == 2) { src = X1 + (size_t)r * DM; dst = X1 + (size_t)r * DM; }
                else { src = X1 + (size_t)r * DM; dst = r < NP ? yp + (size_t)r * DM : (r < MV ? ys + (size_t)(r - NP) * DM : X1 + (size_t)r * DM); }
                float ss = 0.f;
#pragma unroll
                for (int bj = 0; bj < 2; ++bj) { const int c = col0 + bj * HALF;
                    const f32x4 v0 = *(const f32x4*)(src + c) + acc[ai][bj][m][0], v1 = *(const f32x4*)(src + c + 4) + acc[ai][bj][m][1];
                    *(f32x4*)(dst + c) = v0; *(f32x4*)(dst + c + 4) = v1;
                    if (MODE != 3) { ss += (v0[0] * v0[0] + v0[1] * v0[1]) + (v0[2] * v0[2] + v0[3] * v0[3]) + (v1[0] * v1[0] + v1[1] * v1[1]) + (v1[2] * v1[2] + v1[3] * v1[3]);
                        *(u32x4*)(Aout + (size_t)r * DM + c) = pack8(v0 * gv[bj][0], v1 * gv[bj][1]); } }
                if (MODE != 3) { ss += __shfl_xor(ss, 16); ss += __shfl_xor(ss, 32); if (fq == 0) SSQ[(size_t)r * 32 + u.pn * 4 + wc] = ss; }
                if (m & 1) asm volatile("" ::: "memory"); }
    }
};
__device__ __forceinline__ float row_rstd(const float* SSQ, int r, int fq) {
    const float* p = SSQ + (size_t)r * 32 + fq * 8; const f32x4 t0 = *(const f32x4*)p, t1 = *(const f32x4*)(p + 4);
    float s = (t0[0] + t0[1]) + (t0[2] + t0[3]) + (t1[0] + t1[1]) + (t1[2] + t1[3]); s += __shfl_xor(s, 16); s += __shfl_xor(s, 32);
    return rsqrtf(s * (1.f / DM) + EPS);
}
struct EpiQ {
    static constexpr bool PERM = true, AFTER_DRAIN = false;
    const float* SSQ; bf16_t* O; float scale;
    __device__ __forceinline__ void operator()(const Acc& acc, const Unit& u, int wr, int wc, int fr, int fq) const {
        const int row0 = u.pm * BM + wr * 64 + fr, col0 = u.pn * BM + wc * 32 + 8 * fq;
#pragma unroll
        for (int ai = 0; ai < 2; ++ai)
#pragma unroll
            for (int m = 0; m < 4; ++m) { const int r = row0 + ai * HALF + m * 16; const float rs = row_rstd(SSQ, r, fq) * scale; bf16_t* rowp = O + (size_t)r * DM + col0;
#pragma unroll
                for (int bj = 0; bj < 2; ++bj) *(u32x4*)(rowp + bj * HALF) = pack8(acc[ai][bj][m][0] * rs, acc[ai][bj][m][1] * rs); }
    }
};
struct EpiGU {
    static constexpr bool PERM = true, AFTER_DRAIN = false;
    const float* SSQ; bf16_t* H;
    __device__ __forceinline__ void operator()(const Acc& acc, const Unit& u, int wr, int wc, int fr, int fq) const {
        const int row0 = u.pm * BM + wr * 64 + fr, col0 = u.pn * HALF + wc * 32 + 8 * fq;
#pragma unroll
        for (int ai = 0; ai < 2; ++ai)
#pragma unroll
            for (int m = 0; m < 4; ++m) { const int r = row0 + ai * HALF + m * 16; const float rs = SSQ ? row_rstd(SSQ, r, fq) : 1.f; f32x4 hv[2];
#pragma unroll
                for (int n = 0; n < 2; ++n)
#pragma unroll
                    for (int j = 0; j < 4; ++j) { const float gg = acc[ai][0][m][n][j] * rs, uu = acc[ai][1][m][n][j] * rs; hv[n][j] = gg * sigmoidf_(gg) * uu; }
                *(u32x4*)(H + (size_t)r * DFF + col0) = pack8(hv[0], hv[1]); }
    }
};
struct EpiSoftmax {
    static constexpr bool PERM = true, AFTER_DRAIN = true;
    bf16_t* P;
    __device__ __forceinline__ void operator()(const Acc&, const Unit&, int, int, int, int) const {}
    __device__ __forceinline__ void fused(Acc& acc, const Unit& u, int wr, int wc, int fr, int fq, LAS unsigned char* lds, int wid, int lane) const {
        LAS float* PM = (LAS float*)lds; LAS float* PS = (LAS float*)(lds + 4096);
#pragma unroll
        for (int ai = 0; ai < 2; ++ai)
#pragma unroll
            for (int m = 0; m < 4; ++m) { float mx = -3.0e38f;
#pragma unroll
                for (int bj = 0; bj < 2; ++bj)
#pragma unroll
                    for (int n = 0; n < 2; ++n) { const f32x4 x = acc[ai][bj][m][n]; mx = fmaxf(mx, fmaxf(fmaxf(x[0], x[1]), fmaxf(x[2], x[3]))); }
                mx = fmaxf(mx, __shfl_xor(mx, 16)); mx = fmaxf(mx, __shfl_xor(mx, 32));
                if (fq == 0) PM[(ai * HALF + wr * 64 + m * 16 + fr) * 4 + wc] = mx; }
        LDS_WAIT(); __builtin_amdgcn_s_barrier(); asm volatile("" ::: "memory");
#pragma unroll
        for (int ai = 0; ai < 2; ++ai)
#pragma unroll
            for (int m = 0; m < 4; ++m) { const int rl = ai * HALF + wr * 64 + m * 16 + fr; const f32x4 pm = *(const LAS f32x4*)(PM + rl * 4);
                const float M = fmaxf(fmaxf(pm[0], pm[1]), fmaxf(pm[2], pm[3])); float s = 0.f;
#pragma unroll
                for (int bj = 0; bj < 2; ++bj)
#pragma unroll
                    for (int n = 0; n < 2; ++n)
#pragma unroll
                        for (int j = 0; j < 4; ++j) { const float e = __expf(acc[ai][bj][m][n][j] - M); acc[ai][bj][m][n][j] = e; s += e; }
                s += __shfl_xor(s, 16); s += __shfl_xor(s, 32);
                if (fq == 0) PS[rl * 4 + wc] = s; }
        LDS_WAIT(); __builtin_amdgcn_s_barrier(); asm volatile("" ::: "memory");
        const int b = u.pm >> 3, qt = u.pm & 7, h = u.pn;
#pragma unroll
        for (int ai = 0; ai < 2; ++ai)
#pragma unroll
            for (int m = 0; m < 4; ++m) { const int rl = ai * HALF + wr * 64 + m * 16 + fr; const f32x4 ps = *(const LAS f32x4*)(PS + rl * 4);
                const float inv = __builtin_amdgcn_rcpf((ps[0] + ps[1]) + (ps[2] + ps[3]));
                bf16_t* rowp = P + ((size_t)((b * 4 + h) * 2048 + qt * 256 + rl)) * 256 + wc * 32 + 8 * fq;
#pragma unroll
                for (int bj = 0; bj < 2; ++bj) *(u32x4*)(rowp + bj * HALF) = pack8(acc[ai][bj][m][0] * inv, acc[ai][bj][m][1] * inv); }
        LDS_WAIT(); __builtin_amdgcn_s_barrier(); asm volatile("" ::: "memory");
    }
};

struct SchedSK {
    const char* A; const char* B; int ldb, npn, nks, G, c;
    __device__ bool next(int i, Unit& u) const { const int L = i * G + c; if (L >= npn * nks) return false; u.pn = L % npn; u.pm = L / npn; return true; }
    __device__ __forceinline__ const char* aptr(const Unit& u) const { return A + (size_t)u.pm * 512; }
    __device__ __forceinline__ const char* bptr(const Unit& u) const { return B + ((size_t)u.pn * 256 * ldb + (size_t)u.pm * 256) * 2; }
};
struct EpiPartial {
    static constexpr bool PERM = true, AFTER_DRAIN = false;
    float* D; int ld;
    __device__ __forceinline__ void operator()(const Acc& acc, const Unit& u, int wr, int wc, int fr, int fq) const {
        const int col0 = u.pn * BM + wc * 32 + 8 * fq;
#pragma unroll
        for (int m = 0; m < 4; ++m) { float* rowp = D + ((size_t)u.pm * 128 + wr * 64 + m * 16 + fr) * ld + col0;
#pragma unroll
            for (int bj = 0; bj < 2; ++bj) { *(f32x4*)(rowp + bj * HALF) = acc[0][bj][m][0]; *(f32x4*)(rowp + bj * HALF + 4) = acc[0][bj][m][1]; } }
    }
};

struct EpiFinal {
    static constexpr bool PERM = true, AFTER_DRAIN = true;
    const float* X1; float* yp; const float* g; float* slots; unsigned* cnt;
    __device__ __forceinline__ void operator()(const Acc&, const Unit&, int, int, int, int) const {}
    __device__ __forceinline__ void fused(Acc& acc, const Unit& u, int wr, int wc, int fr, int fq, LAS unsigned char* lds, int wid, int lane) const {
        LAS float* P = (LAS float*)lds;
        LAS float* S = (LAS float*)(lds + 4096);
        const int col0 = u.pn * BM + wc * 32 + 8 * fq;
#pragma unroll
        for (int ai = 0; ai < 2; ++ai)
#pragma unroll
            for (int m = 0; m < 4; ++m) { const int rl = ai * HALF + wr * 64 + m * 16 + fr; const float* src = X1 + (size_t)(u.pm * BM + rl) * DM + col0; float ss = 0.f;
#pragma unroll
                for (int bj = 0; bj < 2; ++bj) { acc[ai][bj][m][0] += *(const f32x4*)(src + bj * HALF); acc[ai][bj][m][1] += *(const f32x4*)(src + bj * HALF + 4);
                    const f32x4 v0 = acc[ai][bj][m][0], v1 = acc[ai][bj][m][1];
                    ss += (v0[0] * v0[0] + v0[1] * v0[1]) + (v0[2] * v0[2] + v0[3] * v0[3]) + (v1[0] * v1[0] + v1[1] * v1[1]) + (v1[2] * v1[2] + v1[3] * v1[3]); }
                ss += __shfl_xor(ss, 16); ss += __shfl_xor(ss, 32);
                if (fq == 0) P[rl * 4 + wc] = ss;
                if (m & 1) asm volatile("" ::: "memory"); }
        LDS_WAIT(); __builtin_amdgcn_s_barrier(); asm volatile("" ::: "memory");
        const int row = wid * 32 + (lane & 31);
        if (lane < 32) { const f32x4 p = *(const LAS f32x4*)(P + row * 4);
            __hip_atomic_store(slots + ((size_t)(u.pm * BM + row)) * 8 + u.pn, (p[0] + p[1]) + (p[2] + p[3]), __ATOMIC_RELAXED, __HIP_MEMORY_SCOPE_AGENT); }
        asm volatile("s_waitcnt vmcnt(0)" ::: "memory");
        if (lane == 0) __hip_atomic_fetch_add(cnt + 64 * u.pm, 1u, __ATOMIC_RELAXED, __HIP_MEMORY_SCOPE_AGENT);
        if (wid == 0) {
            unsigned sp = 0u;
            while ((unsigned)__builtin_amdgcn_readfirstlane(__hip_atomic_load(cnt + 64 * u.pm, __ATOMIC_RELAXED, __HIP_MEMORY_SCOPE_AGENT)) < 64u) { __builtin_amdgcn_s_sleep(2); if (++sp > (1u << 20)) break; }
            __builtin_amdgcn_fence(__ATOMIC_ACQUIRE, "agent");
        }
        asm volatile("s_waitcnt vmcnt(0) lgkmcnt(0)" ::: "memory"); __builtin_amdgcn_s_barrier(); asm volatile("" ::: "memory");
        if (lane < 32) { const float* sl = slots + ((size_t)(u.pm * BM + row)) * 8; float tot = 0.f;
#pragma unroll
            for (int t = 0; t < 8; ++t) tot += __hip_atomic_load(sl + t, __ATOMIC_RELAXED, __HIP_MEMORY_SCOPE_AGENT);
            S[row] = rsqrtf(tot * (1.f / DM) + EPS); }
        LDS_WAIT(); __builtin_amdgcn_s_barrier(); asm volatile("" ::: "memory");
        f32x4 gv[2][2];
#pragma unroll
        for (int bj = 0; bj < 2; ++bj)
#pragma unroll
            for (int n = 0; n < 2; ++n) gv[bj][n] = *(const f32x4*)(g + col0 + bj * HALF + 4 * n);
#pragma unroll
        for (int ai = 0; ai < 2; ++ai)
#pragma unroll
            for (int m = 0; m < 4; ++m) { const int rl = ai * HALF + wr * 64 + m * 16 + fr; const float rs = S[rl]; float* dst = yp + (size_t)(u.pm * BM + rl) * DM + col0;
#pragma unroll
                for (int bj = 0; bj < 2; ++bj) { *(f32x4*)(dst + bj * HALF) = acc[ai][bj][m][0] * rs * gv[bj][0]; *(f32x4*)(dst + bj * HALF + 4) = acc[ai][bj][m][1] * rs * gv[bj][1]; } }
        LDS_WAIT(); __builtin_amdgcn_s_barrier(); asm volatile("" ::: "memory");
    }
};

template <class Epi, class Sched, bool ALIGN_EPI>
__device__ __forceinline__ void gemm_phase(LAS unsigned char* lds, const int lda, const int ldb, const int K, const Sched& S, const Epi& E) {
    const int tid = threadIdx.x, wid = __builtin_amdgcn_readfirstlane(tid >> 6), lane = tid & 63, wr = wid >> 2, wc = wid & 3, fr = lane & 15, fq = lane >> 4;
    const int nt = K / BK;
    unsigned voffA[2], voffB[2];
#pragma unroll
    for (int i = 0; i < 2; ++i) { int R, C; stage_rc(tid * 16 + i * 8192, R, C); const int Rb = Epi::PERM ? ((R & ~31) + perm32(R & 31)) : R;
        voffA[i] = (unsigned)(R * lda + C) * 2u; voffB[i] = (unsigned)(Rb * ldb + C) * 2u; }
    const size_t kstep = (size_t)(BK * 2);
    const size_t hA = (size_t)HALF * lda * 2, hB = (size_t)HALF * ldb * 2;
    const unsigned ldsw = (unsigned)wid * 1024u;
    const int aoff = lds_byte(wr * 64 + fr, fq * 8), boff = lds_byte(wc * 32 + fr, fq * 8);
#define PG8_SA(b, h) (((b) * 2 + (h)) * HTB)
#define PG8_SB(b, h) ((4 + (b) * 2 + (h)) * HTB)
#define PG8_STAGE(bufoff, gbase, voff) do { _Pragma("unroll") for (int _i = 0; _i < 2; ++_i) \
        __builtin_amdgcn_global_load_lds((const unsigned*)((const char*)(gbase) + (voff)[_i]), (LAS unsigned*)(lds + (bufoff) + ldsw + _i * 8192), 16, 0, 0); } while (0)
#define PG8_LDA(dst, b, h) do { _Pragma("unroll") for (int m = 0; m < 4; ++m) _Pragma("unroll") for (int k = 0; k < 2; ++k) dst[m][k] = *(const LAS bf16x8*)(lds + PG8_SA(b, h) + aoff + m * 2048 + k * 1024); } while (0)
#define PG8_LDB(dst, b, h) do { _Pragma("unroll") for (int n = 0; n < 2; ++n) _Pragma("unroll") for (int k = 0; k < 2; ++k) dst[n][k] = *(const LAS bf16x8*)(lds + PG8_SB(b, h) + boff + n * 2048 + k * 1024); } while (0)
#define PG8_MMA(ai, bj, At, Bt) do { __builtin_amdgcn_s_setprio(1); _Pragma("unroll") for (int m = 0; m < 4; ++m) _Pragma("unroll") for (int n = 0; n < 2; ++n) _Pragma("unroll") for (int k = 0; k < 2; ++k) \
        acc[ai][bj][m][n] = __builtin_amdgcn_mfma_f32_16x16x32_bf16(Bt[n][k], At[m][k], acc[ai][bj][m][n], 0, 0, 0); __builtin_amdgcn_s_setprio(0); } while (0)
#define PG8_WAIT_V(n) asm volatile("s_waitcnt vmcnt(" #n ")" ::: "memory")
#define PG8_WAIT_L(n) asm volatile("s_waitcnt lgkmcnt(" #n ")" ::: "memory")
#define PG8_BAR __builtin_amdgcn_s_barrier()
#define PG8_SCHED __builtin_amdgcn_sched_barrier(0)
    Unit cur, nxt; int ui = 0;
    if (!S.next(0, cur)) return;
    Acc acc;
#pragma unroll
    for (int a = 0; a < 2; ++a)
#pragma unroll
        for (int b = 0; b < 2; ++b)
#pragma unroll
            for (int m = 0; m < 4; ++m)
#pragma unroll
                for (int n = 0; n < 2; ++n) acc[a][b][m][n] = (f32x4){0.f, 0.f, 0.f, 0.f};
    bf16x8 At[4][2], B0[2][2], B1[2][2];
    const char* cA = S.aptr(cur); const char* cB = S.bptr(cur);
    PG8_STAGE(PG8_SB(0, 0), cB, voffB); PG8_STAGE(PG8_SB(0, 1), cB + hB, voffB); PG8_STAGE(PG8_SA(0, 0), cA, voffA); PG8_STAGE(PG8_SA(0, 1), cA + hA, voffA);
    if (wr == 1) PG8_BAR;
    PG8_WAIT_V(2); PG8_BAR;
    PG8_STAGE(PG8_SB(1, 0), cB + kstep, voffB); PG8_STAGE(PG8_SA(1, 0), cA + kstep, voffA); PG8_STAGE(PG8_SB(1, 1), cB + hB + kstep, voffB);
    PG8_WAIT_V(6); PG8_BAR;
    for (;;) {
        const bool has_next = S.next(ui + 1, nxt);
        const char* nA = has_next ? S.aptr(nxt) : cA; const char* nB = has_next ? S.bptr(nxt) : cB;
#pragma unroll 1
        for (int t = 0; t < nt; t += 2) {
            const bool last = (t == nt - 2);
            const char* a1 = cA + (size_t)(t + 1) * kstep;
            const char* a2 = last ? nA : cA + (size_t)(t + 2) * kstep; const char* b2 = last ? nB : cB + (size_t)(t + 2) * kstep;
            const char* a3 = a2 + kstep; const char* b3 = b2 + kstep;
            PG8_LDB(B0, 0, 0); PG8_LDB(B1, 0, 1); PG8_SCHED; PG8_LDA(At, 0, 0); PG8_STAGE(PG8_SA(1, 1), a1 + hA, voffA);
            PG8_WAIT_V(8); PG8_WAIT_L(0); PG8_BAR; PG8_MMA(0, 0, At, B0); PG8_MMA(0, 1, At, B1); PG8_BAR; PG8_SCHED;
            PG8_LDA(At, 0, 1); PG8_STAGE(PG8_SB(0, 0), b2, voffB); PG8_STAGE(PG8_SB(0, 1), b2 + hB, voffB); PG8_STAGE(PG8_SA(0, 0), a2, voffA);
            PG8_WAIT_V(8); PG8_WAIT_L(0); PG8_BAR; PG8_MMA(1, 0, At, B0); PG8_MMA(1, 1, At, B1); PG8_BAR; PG8_SCHED;
            PG8_LDB(B0, 1, 0); PG8_LDB(B1, 1, 1); PG8_SCHED; PG8_LDA(At, 1, 0); PG8_STAGE(PG8_SA(0, 1), a2 + hA, voffA);
            PG8_WAIT_V(8); PG8_WAIT_L(0); PG8_BAR; PG8_MMA(0, 0, At, B0); PG8_MMA(0, 1, At, B1); PG8_BAR; PG8_SCHED;
            PG8_LDA(At, 1, 1); PG8_STAGE(PG8_SB(1, 0), b3, voffB); PG8_STAGE(PG8_SB(1, 1), b3 + hB, voffB); PG8_STAGE(PG8_SA(1, 0), a3, voffA);
            PG8_WAIT_V(8); PG8_WAIT_L(0); PG8_BAR; PG8_MMA(1, 0, At, B0); PG8_MMA(1, 1, At, B1); PG8_BAR; PG8_SCHED;
        }
        if constexpr (ALIGN_EPI) { if (wr == 0) PG8_BAR; }
        if constexpr (!Epi::AFTER_DRAIN) { E(acc, cur, wr, wc, fr, fq); }
        if (!has_next) break;
#pragma unroll
        for (int a = 0; a < 2; ++a)
#pragma unroll
            for (int b = 0; b < 2; ++b)
#pragma unroll
                for (int m = 0; m < 4; ++m)
#pragma unroll
                    for (int n = 0; n < 2; ++n) acc[a][b][m][n] = (f32x4){0.f, 0.f, 0.f, 0.f};
        cur = nxt; cA = nA; cB = nB; ++ui;
        if constexpr (ALIGN_EPI) { if (wr == 1) PG8_BAR; }
    }
    PG8_WAIT_V(0);
    if constexpr (!ALIGN_EPI) { if (wr == 0) PG8_BAR; }
    PG8_BAR;
    if constexpr (Epi::AFTER_DRAIN) { E.fused(acc, cur, wr, wc, fr, fq, lds, wid, lane); }
#undef PG8_SA
#undef PG8_SB
#undef PG8_STAGE
#undef PG8_LDA
#undef PG8_LDB
#undef PG8_MMA
#undef PG8_WAIT_V
#undef PG8_WAIT_L
#undef PG8_BAR
#undef PG8_SCHED
}
}

struct Args { const float* in[35]; float* out; unsigned char* ws; int ph_lo, ph_hi; };
enum { I_XP = 0, I_XS, I_MEM, I_SRGH, I_SRGC, I_SMLC, I_SMLN, I_SMLM, I_CK, I_CV, I_GMIX, I_WIN, I_CONVW, I_CONVB, I_WRGA, I_BRGA, I_WRGX, I_BRGX, I_LAM,
       I_BMLI, I_BMLF, I_GRG, I_GML, I_WOUT, I_GXA, I_GMEM, I_WQ, I_WK, I_WV, I_WO, I_GFFN, I_WG, I_WU, I_WD, I_GFIN };

__device__ __forceinline__ void tr_item(const float* W, int ldw, bf16_t* dst, int ldd, LAS float* scr, int lane) {
#pragma unroll
    for (int hf = 0; hf < 2; ++hf) { float v[32];
#pragma unroll
        for (int kk = 0; kk < 32; ++kk) v[kk] = W[(size_t)(hf * 32 + kk) * ldw + lane];
#pragma unroll
        for (int kk = 0; kk < 32; ++kk) scr[(hf * 32 + kk) * 65 + lane] = v[kk]; }
    LDS_WAIT();
    const int c = lane & 7;
#pragma unroll
    for (int j = 0; j < 8; ++j) { const int n = (lane >> 3) + 8 * j; const LAS float* s = scr + (8 * c) * 65 + n;
        u32x4 o; o.x = cvt_pk_bf16(s[0], s[65]); o.y = cvt_pk_bf16(s[2 * 65], s[3 * 65]); o.z = cvt_pk_bf16(s[4 * 65], s[5 * 65]); o.w = cvt_pk_bf16(s[6 * 65], s[7 * 65]);
        *(u32x4*)(dst + (size_t)n * ldd + 8 * c) = o; }
    LDS_WAIT();
}
template <int MAP> __device__ __forceinline__ void tr_mat(int it, const float* W, int ldw, int ncols, bf16_t* dst, int ldd, LAS float* scr, int lane) {
    const int nblk = ncols / 64, kb = it / nblk, nb = it % nblk, k0 = kb * 64, n0 = nb * 64;
    const int drow = MAP == 0 ? n0 : ((n0 >> 7) * 256 + (n0 & 127) + (MAP == 2 ? 128 : 0));
    tr_item(W + (size_t)k0 * ldw + n0, ldw, dst + (size_t)drow * ldd + k0, ldd, scr, lane);
}
__device__ __forceinline__ void pro_row(const float* xrow, const float* g, bf16_t* orow, const float* wg, float* gates_out, int lane) {
    f32x4 v[8]; float ss = 0.f;
#pragma unroll
    for (int j = 0; j < 8; ++j) { v[j] = *(const f32x4*)(xrow + 4 * lane + 256 * j); ss += (v[j][0] * v[j][0] + v[j][1] * v[j][1]) + (v[j][2] * v[j][2] + v[j][3] * v[j][3]); }
    ss = wave_sum(ss); const float rstd = rsqrtf(ss * (1.f / DM) + EPS);
    f32x4 ga0 = {0.f, 0.f, 0.f, 0.f}, ga1 = {0.f, 0.f, 0.f, 0.f};
#pragma unroll
    for (int j = 0; j < 8; ++j) { const f32x4 gj = *(const f32x4*)(g + 4 * lane + 256 * j); v[j] = v[j] * rstd * gj;
        u32x2 w; w.x = cvt_pk_bf16(v[j][0], v[j][1]); w.y = cvt_pk_bf16(v[j][2], v[j][3]); *(u32x2*)(orow + 4 * lane + 256 * j) = w;
        if (wg) {
#pragma unroll
            for (int e = 0; e < 4; ++e) { const float* wp = wg + ((j * 4 + e) * 64 + lane) * 4; ga0 += v[j][e] * *(const f32x4*)wp; ga1 += v[j][e] * *(const f32x4*)(wp + 8192); } } }
    if (wg) {
#pragma unroll
        for (int q = 0; q < 4; ++q) { ga0[q] = wave_sum(ga0[q]); ga1[q] = wave_sum(ga1[q]); }
        if (lane == 0) { *(f32x4*)gates_out = ga0; *(f32x4*)(gates_out + 4) = ga1; } }
}
__device__ __forceinline__ void phase_prologue(const Args& a, unsigned char* lds_, int G) {
    const int tid = threadIdx.x, lane = tid & 63, wave = tid >> 6;
    LAS float* scr = (LAS float*)((LAS unsigned char*)lds_ + wave * 16640);
    const int gw = blockIdx.x * 8 + wave, NGW = G * 8;
    unsigned char* ws = a.ws;
    constexpr int I_IN = 32 * 80, I_SQ = 32 * 32, I_RG = 8 * 4;
    constexpr int NITEMS = I_IN + 2 * I_SQ + 2 * I_RG;
    for (int it = gw; it < NITEMS; it += NGW) {
        int r = it;
        if (r < I_IN) { tr_mat<0>(r, a.in[I_WIN], INW, ZW, (bf16_t*)(ws + WS_WIN), DM, scr, lane); continue; } r -= I_IN;
        if (r < I_SQ) { tr_mat<0>(r, a.in[I_WK], DM, DM, (bf16_t*)(ws + WS_WKV), DM, scr, lane); continue; } r -= I_SQ;
        if (r < I_SQ) { tr_mat<0>(r, a.in[I_WV], DM, DM, (bf16_t*)(ws + WS_WKV) + (size_t)DM * DM, DM, scr, lane); continue; } r -= I_SQ;
        if (r < I_RG) { const int blk = r >> 2; tr_mat<0>(r & 3, a.in[I_WRGA] + blk * 16384, 128, 128, (bf16_t*)(ws + WS_WRG) + blk * 32768, 128, scr, lane); continue; } r -= I_RG;
        { const int blk = r >> 2; tr_mat<0>(r & 3, a.in[I_WRGX] + blk * 16384, 128, 128, (bf16_t*)(ws + WS_WRG) + blk * 32768 + 128 * 128, 128, scr, lane); }
    }
    bf16_t* ABUF = (bf16_t*)(ws + WS_ABUF); float* GATES = (float*)(ws + WS_GATES);
    __syncthreads();
    float* wgl = (float*)lds_;
    for (int idx = tid; idx < 4096; idx += 512) { const int k = idx >> 1, hf = idx & 1; const int slot = ((k >> 8) * 4 + (k & 3)) * 64 + ((k & 255) >> 2);
        *(f32x4*)(wgl + hf * 8192 + slot * 4) = *(const f32x4*)(a.in[I_WIN] + (size_t)k * INW + ZW + hf * 4); }
    __syncthreads();
    for (int r = gw; r < MA; r += NGW) {
        if (r < MV) { const float* xrow = r < NP ? a.in[I_XP] + (size_t)r * DM : a.in[I_XS] + (size_t)(r - NP) * DM;
            pro_row(xrow, a.in[I_GMIX], ABUF + (size_t)r * DM, wgl, GATES + (size_t)r * 8, lane); }
        else {
#pragma unroll
            for (int j = 0; j < 8; ++j) *(u32x2*)(ABUF + (size_t)r * DM + 4 * lane + 256 * j) = (u32x2){0u, 0u}; }
    }
    for (int r = gw; r < 1024; r += NGW) pro_row(a.in[I_MEM] + (size_t)r * DM, a.in[I_GMEM], (bf16_t*)(ws + WS_MN) + (size_t)r * DM, nullptr, nullptr, lane);
}

constexpr int LATE_ITEMS = 3 * 32 * 88 + 3 * 32 * 32;
__device__ __forceinline__ void late_transposes(const Args& a, unsigned char* lds_, int first, int last, int wslot, int nslots) {
    const int lane = threadIdx.x & 63, wave = threadIdx.x >> 6;
    LAS float* scr = (LAS float*)((LAS unsigned char*)lds_ + wave * 16640);
    constexpr int I_GU = 32 * 88;
    for (int it = first + wslot; it < last; it += nslots) {
        int r = it;
        if (r < I_GU) { tr_mat<1>(r, a.in[I_WG], DFF, DFF, (bf16_t*)(a.ws + WS_WGU), DM, scr, lane); continue; } r -= I_GU;
        if (r < I_GU) { tr_mat<2>(r, a.in[I_WU], DFF, DFF, (bf16_t*)(a.ws + WS_WGU), DM, scr, lane); continue; } r -= I_GU;
        if (r < I_GU) { tr_mat<0>(r, a.in[I_WD], DM, DM, (bf16_t*)(a.ws + WS_WD), DFF, scr, lane); continue; } r -= I_GU;
        if (r < 1024) { tr_mat<0>(r, a.in[I_WOUT], DM, DM, (bf16_t*)(a.ws + WS_WOUT), DM, scr, lane); continue; } r -= 1024;
        if (r < 1024) { tr_mat<0>(r, a.in[I_WQ], DM, DM, (bf16_t*)(a.ws + WS_WQ), DM, scr, lane); continue; } r -= 1024;
        tr_mat<0>(r, a.in[I_WO], DM, DM, (bf16_t*)(a.ws + WS_WO), DM, scr, lane);
    }
}

__device__ __forceinline__ void unpack8(const u32x4 w, float* f) { f[0] = bflo(w.x); f[1] = bfhi(w.x); f[2] = bflo(w.y); f[3] = bfhi(w.y); f[4] = bflo(w.z); f[5] = bfhi(w.z); f[6] = bflo(w.w); f[7] = bfhi(w.w); }

__device__ __forceinline__ void rg_item(const Args& a, unsigned char* lds_, int b, int blk, int seg) {
    const int tid = threadIdx.x, lane = tid & 63, wave = tid >> 6;
    unsigned char* ws = a.ws;
    const bf16_t* Z = (const bf16_t*)(ws + WS_Z); float* YPRE = (float*)(ws + WS_YPRE); float* CPRE = (float*)(ws + WS_CPRE); float* RGE = (float*)(ws + WS_RGE);
    bf16_t* XRb = (bf16_t*)lds_;
    float* XRf = (float*)(lds_ + 17408);
    float* Gs = (float*)(lds_ + 17408 + 32768);
    bf16x8 bfr[2][4];
    { const bf16_t* wrg = (const bf16_t*)(ws + WS_WRG) + blk * 32768;
#pragma unroll
      for (int nt = 0; nt < 2; ++nt)
#pragma unroll
          for (int ks = 0; ks < 4; ++ks) bfr[nt][ks] = *(const bf16x8*)(wrg + (wave * 32 + nt * 16 + (lane & 15)) * 128 + ks * 32 + (lane >> 4) * 8); }
    const int c8 = tid & 15, chb = blk * 128 + c8 * 8;
    float cw[4][8], cb[8];
#pragma unroll
    for (int e = 0; e < 8; ++e) { cb[e] = a.in[I_CONVB][chb + e];
#pragma unroll
        for (int j = 0; j < 4; ++j) cw[j][e] = a.in[I_CONVW][j * 1024 + chb + e]; }
    float bias[2];
#pragma unroll
    for (int nt = 0; nt < 2; ++nt) { const int col = wave * 32 + nt * 16 + (lane & 15); bias[nt] = col < 128 ? a.in[I_BRGA][blk * 128 + col] : a.in[I_BRGX][blk * 128 + col - 128]; }
    const int cc = tid & 127;
    float sp; { const float nl = -a.in[I_LAM][blk * 128 + cc]; sp = nl > 20.f ? nl : log1pf(__expf(nl)); }
    float hcar = 0.f, pcar = 1.f;
    u32x4 zpre[2][4];
    { const int t0 = seg * 512;
#pragma unroll
      for (int i = 0; i < 2; ++i)
#pragma unroll
          for (int j = 0; j < 4; ++j) { const int tt = t0 + ((tid + 512 * i) >> 4) - 3 + j; zpre[i][j] = tt >= 0 ? *(const u32x4*)(Z + ((size_t)b * SEQ + tt) * ZW + chb) : (u32x4){0u, 0u, 0u, 0u}; } }
    for (int tile = 0; tile < 8; ++tile) {
        const int t0 = seg * 512 + tile * 64; const size_t R0 = (size_t)b * SEQ + t0;
#pragma unroll
        for (int i = 0; i < 2; ++i) { const int t = (tid + 512 * i) >> 4; float xr[8];
#pragma unroll
            for (int e = 0; e < 8; ++e) xr[e] = cb[e];
#pragma unroll
            for (int j = 0; j < 4; ++j) { float z[8]; unpack8(zpre[i][j], z);
#pragma unroll
                for (int e = 0; e < 8; ++e) xr[e] += cw[j][e] * z[e]; }
            *(f32x4*)(XRf + t * 128 + c8 * 8) = (f32x4){xr[0], xr[1], xr[2], xr[3]}; *(f32x4*)(XRf + t * 128 + c8 * 8 + 4) = (f32x4){xr[4], xr[5], xr[6], xr[7]};
            u32x4 w; w.x = cvt_pk_bf16(xr[0], xr[1]); w.y = cvt_pk_bf16(xr[2], xr[3]); w.z = cvt_pk_bf16(xr[4], xr[5]); w.w = cvt_pk_bf16(xr[6], xr[7]);
            *(u32x4*)(XRb + t * 136 + c8 * 8) = w; }
        if (tile < 7) {
#pragma unroll
            for (int i = 0; i < 2; ++i)
#pragma unroll
                for (int j = 0; j < 4; ++j) { const int tt = t0 + 64 + ((tid + 512 * i) >> 4) - 3 + j; zpre[i][j] = *(const u32x4*)(Z + ((size_t)b * SEQ + tt) * ZW + chb); } }
        LBAR();
        { f32x4 acc[4][2];
#pragma unroll
          for (int mt = 0; mt < 4; ++mt)
#pragma unroll
              for (int nt = 0; nt < 2; ++nt) acc[mt][nt] = (f32x4){0.f, 0.f, 0.f, 0.f};
#pragma unroll
          for (int mt = 0; mt < 4; ++mt)
#pragma unroll
              for (int ks = 0; ks < 4; ++ks) { const bf16x8 af = *(const bf16x8*)(XRb + (mt * 16 + (lane & 15)) * 136 + ks * 32 + (lane >> 4) * 8);
#pragma unroll
                  for (int nt = 0; nt < 2; ++nt) acc[mt][nt] = __builtin_amdgcn_mfma_f32_16x16x32_bf16(af, bfr[nt][ks], acc[mt][nt], 0, 0, 0); }
#pragma unroll
          for (int mt = 0; mt < 4; ++mt)
#pragma unroll
              for (int nt = 0; nt < 2; ++nt)
#pragma unroll
                  for (int j = 0; j < 4; ++j) Gs[(mt * 16 + (lane >> 4) * 4 + j) * 256 + wave * 32 + nt * 16 + (lane & 15)] = sigmoidf_(acc[mt][nt][j] + bias[nt]); }
        LBAR();
#pragma unroll 4
        for (int i = 0; i < 16; ++i) { const int t = (tid + 512 * i) >> 7; const float r = Gs[t * 256 + cc], ig = Gs[t * 256 + 128 + cc];
            const float la = -8.f * r * sp, av = __expf(la), mult = __builtin_amdgcn_sqrtf(fmaxf(1.f - __expf(2.f * la), 0.f));
            Gs[t * 256 + cc] = av; Gs[t * 256 + 128 + cc] = mult * ig * XRf[t * 128 + cc]; }
        LBAR();
        if (tid < 128) {
#pragma unroll 8
            for (int t = 0; t < 64; ++t) { const float av = Gs[t * 256 + tid]; hcar = av * hcar + Gs[t * 256 + 128 + tid]; pcar *= av; Gs[t * 256 + tid] = hcar; Gs[t * 256 + 128 + tid] = pcar; } }
        LBAR();
#pragma unroll
        for (int i = 0; i < 2; ++i) { const int t = (tid + 512 * i) >> 4; const float* gp = Gs + t * 256 + c8 * 8;
            float* yp = YPRE + (R0 + t) * 1024 + chb; *(f32x4*)yp = *(const f32x4*)gp; *(f32x4*)(yp + 4) = *(const f32x4*)(gp + 4);
            float* pp = CPRE + (R0 + t) * 1024 + chb; *(f32x4*)pp = *(const f32x4*)(gp + 128); *(f32x4*)(pp + 4) = *(const f32x4*)(gp + 132); }
    }
    if (tid < 128) { RGE[((size_t)(b * 4 + seg) * 2 + 0) * 1024 + blk * 128 + tid] = hcar; RGE[((size_t)(b * 4 + seg) * 2 + 1) * 1024 + blk * 128 + tid] = pcar; }
    if (seg == 3 && tid < 384) { const int j = tid >> 7, c = tid & 127; a.out[O_PRGC + ((size_t)b * 3 + j) * 1024 + blk * 128 + c] = bf2f(Z[((size_t)b * SEQ + 2045 + j) * ZW + blk * 128 + c]); }
    __syncthreads();
}

__device__ __forceinline__ void ml_item(const Args& a, unsigned char* lds_, int b, int h, int sl, int seg) {
    const int tid = threadIdx.x, lane = tid & 63, wave = tid >> 6, l15 = lane & 15, lq = lane >> 4;
    unsigned char* ws = a.ws;
    const bf16_t* Z = (const bf16_t*)(ws + WS_Z); const float* GATES = (const float*)(ws + WS_GATES); float* HPRE = (float*)(ws + WS_HPRE); float* MLS = (float*)(ws + WS_MLS);
    bf16_t* Qs = (bf16_t*)lds_;
    bf16_t* Ks = (bf16_t*)(lds_ + 17408);
    bf16_t* Vt = (bf16_t*)(lds_ + 34816);
    bf16_t* Kwt = (bf16_t*)(lds_ + 46336);
    bf16_t* Ss = (bf16_t*)(lds_ + 64768);
    bf16_t* Ctb = (bf16_t*)(lds_ + 73984);
    float* Out = (float*)(lds_ + 95744);
    float* Aa = (float*)(lds_ + 116480);
    float* Am = Aa + 2048;
    float* Bc = Am + 2048;
    const float scale = 0.08838834764831845f;
    for (int i = tid; i < 80 * 136; i += 512) Ctb[i] = 0;
    for (int i = tid; i < 16 * 72; i += 512) Vt[64 * 72 + i] = (i < 72) ? (bf16_t)0x3F80 : (bf16_t)0;
    { const float bi = a.in[I_BMLI][h], bff = a.in[I_BMLF][h];
#pragma unroll
      for (int cI = 0; cI < 4; ++cI) { const int tok = (wave + 8 * cI) * 64 + lane; const size_t R = (size_t)b * SEQ + tok;
          const float gi = GATES[R * 8 + h] + bi, gf = GATES[R * 8 + 4 + h] + bff;
          const float lf = fminf(gf, 0.f) - log1pf(__expf(-fabsf(gf)));
          float bc = lf;
#pragma unroll
          for (int o = 1; o < 64; o <<= 1) { const float t = __shfl_up(bc, o); if (lane >= o) bc += t; }
          const float av = gi - bc; float am = av;
#pragma unroll
          for (int o = 1; o < 64; o <<= 1) { const float t = __shfl_up(am, o); if (lane >= o) am = fmaxf(am, t); }
          Aa[tok] = av; Am[tok] = am; Bc[tok] = bc; } }
    f32x4 cacc[5];
#pragma unroll
    for (int mt = 0; mt < 5; ++mt) cacc[mt] = (f32x4){0.f, 0.f, 0.f, 0.f};
    float m_prev = 0.f, m_old = 0.f, m_seg = 0.f, Fs = 0.f, Fs_old = 0.f;
    const int pt = tid & 63, pd8 = tid >> 6;
    u32x4 qpre[2], kpre[2], vpre;
#define ML_LOAD(Q, K, V, R0_) do { _Pragma("unroll") for (int i = 0; i < 2; ++i) { Q[i] = *(const u32x4*)(Z + ((R0_) + pt) * ZW + 2048 + h * 128 + (2 * pd8 + i) * 8); K[i] = *(const u32x4*)(Z + ((R0_) + pt) * ZW + 2560 + h * 128 + (2 * pd8 + i) * 8); } \
        V = *(const u32x4*)(Z + ((R0_) + pt) * ZW + 3072 + h * 256 + sl * 64 + pd8 * 8); } while (0)
    { const size_t R0 = (size_t)b * SEQ + seg * 1024; ML_LOAD(qpre, kpre, vpre, R0); }
    __syncthreads();
    for (int c = 0; c < seg * 16; ++c) m_prev = Bc[c * 64 + 63] + fmaxf(m_prev, Am[c * 64 + 63]);
    m_seg = m_prev; m_old = m_prev;
#pragma unroll 1
    for (int ci = 0; ci <= 16; ++ci) {
        const int ch = seg * 16 + ci, c0 = ch * 64;
        const int cq = ci < 16 ? c0 : 0; const float F = Bc[cq + 63], m_new = F + fmaxf(m_prev, Am[cq + 63]), dec = __expf(F + m_prev - m_new);
        if (ci < 16) { const float wend = __expf(F + Aa[c0 + pt] - m_new) * scale;
#pragma unroll
          for (int i = 0; i < 2; ++i) { const int d8 = 2 * pd8 + i;
              *(u32x4*)(Qs + pt * 136 + d8 * 8) = qpre[i]; *(u32x4*)(Ks + pt * 136 + d8 * 8) = kpre[i];
              float kf[8]; unpack8(kpre[i], kf); bf16_t* kp = Kwt + (d8 * 8) * 72 + pt;
#pragma unroll
              for (int e = 0; e < 8; ++e) kp[e * 72] = f2bf(kf[e] * wend); }
          bf16_t* vp = Vt + (pd8 * 8) * 72 + pt; const u32x4 w = vpre;
          vp[0] = (bf16_t)(w.x & 0xffff); vp[72] = (bf16_t)(w.x >> 16); vp[144] = (bf16_t)(w.y & 0xffff); vp[216] = (bf16_t)(w.y >> 16);
          vp[288] = (bf16_t)(w.z & 0xffff); vp[360] = (bf16_t)(w.z >> 16); vp[432] = (bf16_t)(w.w & 0xffff); vp[504] = (bf16_t)(w.w >> 16); }
        if (ci > 0) { const size_t R1 = (size_t)b * SEQ + c0 - 64;
#pragma unroll
            for (int mt = 0; mt < 5; ++mt)
#pragma unroll
                for (int j = 0; j < 4; ++j) Ctb[(mt * 16 + lq * 4 + j) * 136 + wave * 16 + l15] = f2bf(cacc[mt][j]);
#pragma unroll
            for (int i = 0; i < 8; ++i) { const int idx = tid + 512 * i, v = idx & 63, t = idx >> 6; HPRE[(R1 + t) * 1024 + h * 256 + sl * 64 + v] = Out[t * 81 + v]; }
            if (sl == 0 && tid < 64) { const int t = tid; const float mtv = Bc[c0 - 64 + t] + fmaxf(m_old, Am[c0 - 64 + t]);
                f32x4 o; o[0] = Out[t * 81 + 64]; o[1] = __expf(-mtv); o[2] = seg ? __expf(Fs_old + Bc[c0 - 64 + t] + m_seg - mtv) : 0.f; o[3] = 0.f;
                *(f32x4*)(MLS + ((R1 + t) * 4 + h) * 4) = o; } }
        if (ci == 16) break;
        if (ci < 15) { const size_t R0 = (size_t)b * SEQ + c0 + 64; ML_LOAD(qpre, kpre, vpre, R0); }
        LBAR();
        { const int mt = wave >> 1; bf16x8 afq[4]; f32x4 acc2[2] = {{0.f, 0.f, 0.f, 0.f}, {0.f, 0.f, 0.f, 0.f}};
#pragma unroll
          for (int ks = 0; ks < 4; ++ks) afq[ks] = *(const bf16x8*)(Qs + (mt * 16 + l15) * 136 + ks * 32 + lq * 8);
#pragma unroll
          for (int ks = 0; ks < 4; ++ks)
#pragma unroll
              for (int n = 0; n < 2; ++n) { const int nt = 2 * (wave & 1) + n; const bf16x8 bfv = *(const bf16x8*)(Ks + (nt * 16 + l15) * 136 + ks * 32 + lq * 8);
                  acc2[n] = __builtin_amdgcn_mfma_f32_16x16x32_bf16(afq[ks], bfv, acc2[n], 0, 0, 0); }
#pragma unroll
          for (int n = 0; n < 2; ++n) { const int nt = 2 * (wave & 1) + n; const int sI = nt * 16 + l15; const float as = Aa[c0 + sI];
#pragma unroll
              for (int j = 0; j < 4; ++j) { const int t = mt * 16 + lq * 4 + j; const float v = (sI <= t) ? acc2[n][j] * scale * __expf(as - fmaxf(m_prev, Am[c0 + t])) : 0.f; Ss[t * 72 + sI] = f2bf(v); } } }
        LBAR();
        { const int mt = wave & 3, nt0 = wave < 4 ? 0 : 3, nn = wave < 4 ? 3 : 2; bf16x8 afq[4], afs[2]; f32x4 acc3[3];
#pragma unroll
          for (int n = 0; n < 3; ++n) acc3[n] = (f32x4){0.f, 0.f, 0.f, 0.f};
#pragma unroll
          for (int ks = 0; ks < 4; ++ks) afq[ks] = *(const bf16x8*)(Qs + (mt * 16 + l15) * 136 + ks * 32 + lq * 8);
#pragma unroll
          for (int ks = 0; ks < 2; ++ks) afs[ks] = *(const bf16x8*)(Ss + (mt * 16 + l15) * 72 + ks * 32 + lq * 8);
#pragma unroll
          for (int ks = 0; ks < 4; ++ks)
#pragma unroll
              for (int n = 0; n < 3; ++n) if (n < nn) { const bf16x8 bfv = *(const bf16x8*)(Ctb + ((nt0 + n) * 16 + l15) * 136 + ks * 32 + lq * 8);
                  acc3[n] = __builtin_amdgcn_mfma_f32_16x16x32_bf16(afq[ks], bfv, acc3[n], 0, 0, 0); }
          float scv[4];
#pragma unroll
          for (int j = 0; j < 4; ++j) scv[j] = __expf(m_prev - fmaxf(m_prev, Am[c0 + mt * 16 + lq * 4 + j]));
#pragma unroll
          for (int n = 0; n < 3; ++n)
#pragma unroll
              for (int j = 0; j < 4; ++j) acc3[n][j] *= scv[j];
#pragma unroll
          for (int ks = 0; ks < 2; ++ks)
#pragma unroll
              for (int n = 0; n < 3; ++n) if (n < nn) { const bf16x8 bfv = *(const bf16x8*)(Vt + ((nt0 + n) * 16 + l15) * 72 + ks * 32 + lq * 8);
                  acc3[n] = __builtin_amdgcn_mfma_f32_16x16x32_bf16(afs[ks], bfv, acc3[n], 0, 0, 0); }
#pragma unroll
          for (int n = 0; n < 3; ++n) if (n < nn) {
#pragma unroll
              for (int j = 0; j < 4; ++j) Out[(mt * 16 + lq * 4 + j) * 81 + (nt0 + n) * 16 + l15] = acc3[n][j]; } }
#pragma unroll
        for (int mt = 0; mt < 5; ++mt) { cacc[mt] = cacc[mt] * dec;
#pragma unroll
            for (int ks = 0; ks < 2; ++ks) { const bf16x8 af = *(const bf16x8*)(Vt + (mt * 16 + l15) * 72 + ks * 32 + lq * 8), bfv = *(const bf16x8*)(Kwt + (wave * 16 + l15) * 72 + ks * 32 + lq * 8);
                cacc[mt] = __builtin_amdgcn_mfma_f32_16x16x32_bf16(af, bfv, cacc[mt], 0, 0, 0); } }
        m_old = m_prev; m_prev = m_new; Fs_old = Fs; Fs += F;
        LBAR();
    }
#undef ML_LOAD
    if (seg == 0) {
        float* CINF = (float*)(ws + WS_CINF) + (size_t)((b * 4 + h) * 4 + sl) * 80 * 128; bf16_t* CIN = (bf16_t*)(ws + WS_CIN) + (size_t)((b * 4 + h) * 4 + sl) * 80 * 128;
#pragma unroll
        for (int mt = 0; mt < 5; ++mt)
#pragma unroll
            for (int j = 0; j < 4; ++j) { const int o = (mt * 16 + lq * 4 + j) * 128 + wave * 16 + l15; CINF[o] = cacc[mt][j]; CIN[o] = f2bf(cacc[mt][j]); }
    } else {
#pragma unroll
        for (int mt = 0; mt < 4; ++mt)
#pragma unroll
            for (int j = 0; j < 4; ++j) a.out[O_PMLC + ((size_t)((b * 4 + h) * 128 + wave * 16 + l15)) * 256 + sl * 64 + mt * 16 + lq * 4 + j] = cacc[mt][j];
        if (sl == 0) { if (lq == 0) a.out[O_PMLN + (size_t)(b * 4 + h) * 128 + wave * 16 + l15] = cacc[4][0];
            if (tid == 0) { a.out[O_PMLM + b * 4 + h] = m_prev; ((float*)(ws + WS_GL))[b * 4 + h] = __expf(Fs + m_seg - m_prev); } }
    }
    __syncthreads();
}

__device__ __forceinline__ void sample_item(const Args& a, unsigned char* lds_, int b) {
    const int tid = threadIdx.x, lane = tid & 63, wave = tid >> 6;
    unsigned char* ws = a.ws;
    const size_t r = (size_t)NP + b;
    const bf16_t* Zr = (const bf16_t*)(ws + WS_Z) + r * ZW; const float* GATES = (const float*)(ws + WS_GATES) + r * 8;
    float* YPRE = (float*)(ws + WS_YPRE) + r * 1024; float* HPRE = (float*)(ws + WS_HPRE) + r * 1024;
    float* xr = (float*)lds_;
    float* gpre = xr + 1024;
    float* qs = gpre + 2048;
    float* ks = qs + 128;
    float* vs = ks + 128;
    float* red = vs + 256;
    float* dn = red + 2048;
#pragma unroll
    for (int i = 0; i < 2; ++i) { const int c = tid + 512 * i; const float zx = bf2f(Zr[c]);
        const float b0 = a.in[I_SRGC][((size_t)b * 3 + 0) * 1024 + c], b1 = a.in[I_SRGC][((size_t)b * 3 + 1) * 1024 + c], b2 = a.in[I_SRGC][((size_t)b * 3 + 2) * 1024 + c];
        xr[c] = a.in[I_CONVB][c] + a.in[I_CONVW][c] * b0 + a.in[I_CONVW][1024 + c] * b1 + a.in[I_CONVW][2048 + c] * b2 + a.in[I_CONVW][3072 + c] * zx;
        a.out[O_SRGC + ((size_t)b * 3 + 0) * 1024 + c] = b1; a.out[O_SRGC + ((size_t)b * 3 + 1) * 1024 + c] = b2; a.out[O_SRGC + ((size_t)b * 3 + 2) * 1024 + c] = zx; }
    __syncthreads();
    { const int mat = tid >> 8, q = tid & 255, blk = q >> 5, d4 = (q & 31) * 4;
      const float* W = (mat ? a.in[I_WRGX] : a.in[I_WRGA]) + blk * 16384 + d4; const float* xb = xr + blk * 128;
      f32x4 acc = *(const f32x4*)((mat ? a.in[I_BRGX] : a.in[I_BRGA]) + blk * 128 + d4);
#pragma unroll 1
      for (int k0 = 0; k0 < 128; k0 += 16) { f32x4 w[16];
#pragma unroll
          for (int k = 0; k < 16; ++k) w[k] = *(const f32x4*)(W + (size_t)(k0 + k) * 128);
#pragma unroll
          for (int k = 0; k < 16; ++k) acc += w[k] * xb[k0 + k]; }
      *(f32x4*)(gpre + mat * 1024 + blk * 128 + d4) = acc; }
    __syncthreads();
#pragma unroll
    for (int i = 0; i < 2; ++i) { const int c = tid + 512 * i;
        const float rg = sigmoidf_(gpre[c]), ig = sigmoidf_(gpre[1024 + c]); const float nl = -a.in[I_LAM][c]; const float sp = nl > 20.f ? nl : log1pf(__expf(nl));
        const float la = -8.f * rg * sp, av = __expf(la), mult = __builtin_amdgcn_sqrtf(fmaxf(1.f - __expf(2.f * la), 0.f));
        const float hv = av * a.in[I_SRGH][(size_t)b * 1024 + c] + mult * (ig * xr[c]);
        a.out[O_SRGH + (size_t)b * 1024 + c] = hv; YPRE[c] = hv * gelu_tanh(bf2f(Zr[1024 + c])); }
    for (int h = 0; h < 4; ++h) {
        const float* C0 = a.in[I_SMLC] + (size_t)(b * 4 + h) * 128 * 256; float* C1 = a.out + O_SMLC + (size_t)(b * 4 + h) * 128 * 256;
        f32x4 c0[16];
#pragma unroll
        for (int i = 0; i < 16; ++i) c0[i] = *(const f32x4*)(C0 + (size_t)(wave + 8 * i) * 256 + 4 * lane);
        __syncthreads();
        if (tid < 128) { qs[tid] = bf2f(Zr[2048 + h * 128 + tid]); ks[tid] = bf2f(Zr[2560 + h * 128 + tid]) * 0.08838834764831845f; }
        else if (tid < 384) vs[tid - 128] = bf2f(Zr[3072 + h * 256 + tid - 128]);
        const float li = GATES[h] + a.in[I_BMLI][h], gf = GATES[4 + h] + a.in[I_BMLF][h]; const float lf = fminf(gf, 0.f) - log1pf(__expf(-fabsf(gf)));
        const float m0 = a.in[I_SMLM][b * 4 + h]; const float m_new = fmaxf(lf + m0, li), sc = __expf(lf + m0 - m_new), Dv = __expf(li - m_new);
        __syncthreads();
        f32x4 num = {0.f, 0.f, 0.f, 0.f}; const f32x4 v4 = *(const f32x4*)(vs + 4 * lane);
#pragma unroll
        for (int i = 0; i < 16; ++i) { const int d = wave + 8 * i; const f32x4 cn = c0[i] * sc + v4 * (Dv * ks[d]);
            *(f32x4*)(C1 + (size_t)d * 256 + 4 * lane) = cn; num += cn * qs[d]; }
        *(f32x4*)(red + wave * 256 + 4 * lane) = num;
        if (tid < 128) { const float nn = sc * a.in[I_SMLN][(size_t)(b * 4 + h) * 128 + tid] + Dv * ks[tid]; a.out[O_SMLN + (size_t)(b * 4 + h) * 128 + tid] = nn; dn[tid] = nn * qs[tid]; }
        if (tid == 0) a.out[O_SMLM + b * 4 + h] = m_new;
        __syncthreads();
        if (tid < 256) { float den = 0.f;
#pragma unroll 8
            for (int k = 0; k < 128; ++k) den += dn[k];
            den = fmaxf(fabsf(den), __expf(-m_new)); float nv = 0.f;
#pragma unroll
            for (int w = 0; w < 8; ++w) nv += red[w * 256 + tid];
            HPRE[h * 256 + tid] = nv / den; }
    }
    __syncthreads();
}

__device__ __forceinline__ void fin_row(const Args& a, int r, const float* hin, int lane, bool mlnorm) {
    unsigned char* ws = a.ws; const bf16_t* Z = (const bf16_t*)(ws + WS_Z); const float* YPRE = (const float*)(ws + WS_YPRE); const float* CPRE = (const float*)(ws + WS_CPRE);
    const float* HPRE = (const float*)(ws + WS_HPRE); bf16_t* YMIX = (bf16_t*)(ws + WS_YMIX);
    f32x4 y[4]; float ss = 0.f;
#pragma unroll
    for (int j = 0; j < 4; ++j) { y[j] = *(const f32x4*)(YPRE + (size_t)r * 1024 + 4 * lane + 256 * j);
        if (hin) { const f32x4 p = *(const f32x4*)(CPRE + (size_t)r * 1024 + 4 * lane + 256 * j), hi = *(const f32x4*)(hin + 4 * lane + 256 * j);
            const u32x2 zg = *(const u32x2*)(Z + (size_t)r * ZW + 1024 + 4 * lane + 256 * j); y[j] = y[j] + p * hi;
            y[j][0] *= gelu_tanh(bflo(zg.x)); y[j][1] *= gelu_tanh(bfhi(zg.x)); y[j][2] *= gelu_tanh(bflo(zg.y)); y[j][3] *= gelu_tanh(bfhi(zg.y)); }
        ss += (y[j][0] * y[j][0] + y[j][1] * y[j][1]) + (y[j][2] * y[j][2] + y[j][3] * y[j][3]); }
    ss = wave_sum(ss); const float rs = rsqrtf(ss * (1.f / 1024.f) + EPS);
#pragma unroll
    for (int j = 0; j < 4; ++j) { const f32x4 gg = *(const f32x4*)(a.in[I_GRG] + 4 * lane + 256 * j); const f32x4 o = y[j] * rs * gg;
        u32x2 w; w.x = cvt_pk_bf16(o[0], o[1]); w.y = cvt_pk_bf16(o[2], o[3]); *(u32x2*)(YMIX + (size_t)r * DM + 4 * lane + 256 * j) = w; }
#pragma unroll
    for (int j = 0; j < 4; ++j) { f32x4 hv = *(const f32x4*)(HPRE + (size_t)r * 1024 + j * 256 + 4 * lane);
        if (mlnorm) { const f32x4 ms = *(const f32x4*)((const float*)(ws + WS_MLS) + ((size_t)r * 4 + j) * 4); hv = hv * __builtin_amdgcn_rcpf(fmaxf(fabsf(ms[0]), ms[1])); }
        const float s2 = wave_sum((hv[0] * hv[0] + hv[1] * hv[1]) + (hv[2] * hv[2] + hv[3] * hv[3])); const float r2 = rsqrtf(s2 * (1.f / 256.f) + EPS);
        const f32x4 gg = *(const f32x4*)(a.in[I_GML] + j * 256 + 4 * lane); const u32x2 zo = *(const u32x2*)(Z + (size_t)r * ZW + 4096 + j * 256 + 4 * lane);
        f32x4 o = hv * r2 * gg; o[0] *= sigmoidf_(bflo(zo.x)); o[1] *= sigmoidf_(bfhi(zo.x)); o[2] *= sigmoidf_(bflo(zo.y)); o[3] *= sigmoidf_(bfhi(zo.y));
        u32x2 w; w.x = cvt_pk_bf16(o[0], o[1]); w.y = cvt_pk_bf16(o[2], o[3]); *(u32x2*)(YMIX + (size_t)r * DM + 1024 + j * 256 + 4 * lane) = w; }
}
__device__ __forceinline__ void phase_finalize(const Args& a, unsigned char* lds_, int G) {
    const int tid = threadIdx.x, lane = tid & 63, wave = tid >> 6;
    const float* RGE = (const float*)(a.ws + WS_RGE); float* hin = (float*)lds_;
    for (int g = blockIdx.x; g < 256; g += G) {
        const int b = g >> 6, seg = (g >> 4) & 3;
        for (int c = tid; c < 1024; c += 512) { float hh = 0.f;
            for (int q = 0; q < seg; ++q) hh = RGE[((size_t)(b * 4 + q) * 2 + 0) * 1024 + c] + RGE[((size_t)(b * 4 + q) * 2 + 1) * 1024 + c] * hh;
            hin[c] = hh;
            if ((g & 63) == 63) a.out[O_PRGH + (size_t)b * 1024 + c] = RGE[((size_t)(b * 4 + 3) * 2 + 0) * 1024 + c] + RGE[((size_t)(b * 4 + 3) * 2 + 1) * 1024 + c] * hh; }
        if ((g & 63) >= 32) {
            const int hh = wave >> 1, mt = wave & 1, l15 = lane & 15, lq = lane >> 4, r0 = g * 32;
            const bf16_t* Z = (const bf16_t*)(a.ws + WS_Z); float* HPRE = (float*)(a.ws + WS_HPRE); float* MLS = (float*)(a.ws + WS_MLS);
            bf16x8 afq[4]; float gj[4];
#pragma unroll
            for (int ks = 0; ks < 4; ++ks) afq[ks] = *(const bf16x8*)(Z + (size_t)(r0 + mt * 16 + l15) * ZW + 2048 + hh * 128 + ks * 32 + lq * 8);
#pragma unroll
            for (int j = 0; j < 4; ++j) gj[j] = MLS[((size_t)(r0 + mt * 16 + lq * 4 + j) * 4 + hh) * 4 + 2];
            float* hp = HPRE + (size_t)(r0 + mt * 16 + lq * 4) * 1024 + hh * 256 + l15;
#pragma unroll 1
            for (int sl = 0; sl < 4; ++sl) { const bf16_t* cin = (const bf16_t*)(a.ws + WS_CIN) + (size_t)((b * 4 + hh) * 4 + sl) * 80 * 128;
                float old[4][4]; f32x4 acc[4];
#pragma unroll
                for (int nt = 0; nt < 4; ++nt)
#pragma unroll
                    for (int j = 0; j < 4; ++j) old[nt][j] = hp[(size_t)j * 1024 + sl * 64 + nt * 16];
#pragma unroll
                for (int nt = 0; nt < 4; ++nt) { acc[nt] = (f32x4){0.f, 0.f, 0.f, 0.f};
#pragma unroll
                    for (int ks = 0; ks < 4; ++ks) { const bf16x8 bfv = *(const bf16x8*)(cin + (nt * 16 + l15) * 128 + ks * 32 + lq * 8); acc[nt] = __builtin_amdgcn_mfma_f32_16x16x32_bf16(afq[ks], bfv, acc[nt], 0, 0, 0); } }
#pragma unroll
                for (int nt = 0; nt < 4; ++nt)
#pragma unroll
                    for (int j = 0; j < 4; ++j) hp[(size_t)j * 1024 + sl * 64 + nt * 16] = old[nt][j] + gj[j] * acc[nt][j];
                if (sl == 0) { f32x4 an = {0.f, 0.f, 0.f, 0.f};
#pragma unroll
                    for (int ks = 0; ks < 4; ++ks) { const bf16x8 bfv = *(const bf16x8*)(cin + (64 + l15) * 128 + ks * 32 + lq * 8); an = __builtin_amdgcn_mfma_f32_16x16x32_bf16(afq[ks], bfv, an, 0, 0, 0); }
                    if (l15 == 0) {
#pragma unroll
                        for (int j = 0; j < 4; ++j) MLS[((size_t)(r0 + mt * 16 + lq * 4 + j) * 4 + hh) * 4] += gj[j] * an[j]; } } }
        }
        __syncthreads();
        for (int rr = wave; rr < 32; rr += 8) fin_row(a, g * 32 + rr, hin, lane, true);
        __syncthreads();
    }
    {
        const float* CINF = (const float*)(a.ws + WS_CINF); const float* GL = (const float*)(a.ws + WS_GL);
        for (int idx = blockIdx.x * 512 + tid; idx < 16 * 128 * 256; idx += G * 512) { const int bh = idx >> 15, d = (idx >> 8) & 127, v = idx & 255;
            a.out[O_PMLC + idx] += GL[bh] * CINF[((size_t)(bh * 4 + (v >> 6)) * 80 + (v & 63)) * 128 + d]; }
        for (int idx = blockIdx.x * 512 + tid; idx < 16 * 128; idx += G * 512) { const int bh = idx >> 7, d = idx & 127;
            a.out[O_PMLN + idx] += GL[bh] * CINF[((size_t)(bh * 4) * 80 + 64) * 128 + d]; }
    }
    for (int j = blockIdx.x; j < NS; j += G) {
        if (wave == 0) fin_row(a, NP + j, nullptr, lane, false);
        if (wave == 1) {
#pragma unroll
            for (int q = 0; q < 8; ++q) *(u32x2*)((bf16_t*)(a.ws + WS_YMIX) + (size_t)(MV + j) * DM + 4 * lane + 256 * q) = (u32x2){0u, 0u}; }
    }
}

__device__ __forceinline__ void sattn_item(const Args& a, unsigned char* lds_, int b, int h) {
    const int tid = threadIdx.x, lane = tid & 63, wave = tid >> 6;
    unsigned char* ws = a.ws;
    float* SC = (float*)lds_;
    float* RED = SC + 1024;
    float q[8];
    { f32x4 q0 = {0.f, 0.f, 0.f, 0.f}, q1 = {0.f, 0.f, 0.f, 0.f}; const float* qp = (const float*)(ws + WS_P4) + (size_t)b * DM + h * 512 + lane * 8;
#pragma unroll
      for (int k = 0; k < 8; ++k) { q0 += *(const f32x4*)(qp + (size_t)k * NS * DM); q1 += *(const f32x4*)(qp + (size_t)k * NS * DM + 4); }
#pragma unroll
      for (int e = 0; e < 4; ++e) { q[e] = q0[e] * 0.04419417382415922f; q[4 + e] = q1[e] * 0.04419417382415922f; } }
    const float* kb = a.in[I_CK] + ((size_t)b * NMEM * 4 + h) * 512 + lane * 8; const float* vb = a.in[I_CV] + ((size_t)b * NMEM * 4 + h) * 512 + lane * 8;
    float mys = 0.f;
#pragma unroll 8
    for (int mm = 0; mm < 32; ++mm) { const float* p = kb + (size_t)(wave * 32 + mm) * DM; const f32x4 k0 = __builtin_nontemporal_load((const f32x4*)p), k1 = __builtin_nontemporal_load((const f32x4*)(p + 4));
        float d = (k0[0] * q[0] + k0[1] * q[1]) + (k0[2] * q[2] + k0[3] * q[3]) + (k1[0] * q[4] + k1[1] * q[5]) + (k1[2] * q[6] + k1[3] * q[7]);
        d = wave_sum(d); if (lane == mm) mys = d; }
    if (lane < 32) SC[wave * 32 + lane] = mys;
    __syncthreads();
    const float s0 = SC[lane], s1 = SC[64 + lane], s2 = SC[128 + lane], s3 = SC[192 + lane];
    const float mx = wave_max(fmaxf(fmaxf(s0, s1), fmaxf(s2, s3)));
    const float tot = wave_sum((__expf(s0 - mx) + __expf(s1 - mx)) + (__expf(s2 - mx) + __expf(s3 - mx)));
    f32x4 o0 = {0.f, 0.f, 0.f, 0.f}, o1 = {0.f, 0.f, 0.f, 0.f};
#pragma unroll 8
    for (int mm = 0; mm < 32; ++mm) { const int m = wave * 32 + mm; const float* p = vb + (size_t)m * DM; const float pr = __expf(SC[m] - mx);
        o0 += pr * __builtin_nontemporal_load((const f32x4*)p); o1 += pr * __builtin_nontemporal_load((const f32x4*)(p + 4)); }
    *(f32x4*)(RED + wave * 512 + lane * 8) = o0; *(f32x4*)(RED + wave * 512 + lane * 8 + 4) = o1;
    __syncthreads();
    { float s = 0.f;
#pragma unroll
      for (int w = 0; w < 8; ++w) s += RED[w * 512 + tid];
      ((bf16_t*)(ws + WS_OB))[((size_t)NP + b) * DM + h * 512 + tid] = f2bf(s / tot); }
    __syncthreads();
}

__device__ __forceinline__ void sample_prep(const float* X, const float* Pp, int nks, const float* g, bf16_t* Aout, float* Xnext, int lane) {
    f32x4 v[8]; float ss = 0.f;
#pragma unroll
    for (int j = 0; j < 8; ++j) { v[j] = *(const f32x4*)(X + 4 * lane + 256 * j);
        for (int k = 0; k < nks; ++k) v[j] += *(const f32x4*)(Pp + (size_t)k * NS * DM + 4 * lane + 256 * j);
        ss += (v[j][0] * v[j][0] + v[j][1] * v[j][1]) + (v[j][2] * v[j][2] + v[j][3] * v[j][3]); }
    ss = wave_sum(ss); const float rs = rsqrtf(ss * (1.f / DM) + EPS);
#pragma unroll
    for (int j = 0; j < 8; ++j) { *(f32x4*)(Xnext + 4 * lane + 256 * j) = v[j]; const f32x4 o = v[j] * rs * *(const f32x4*)(g + 4 * lane + 256 * j);
        u32x2 w; w.x = cvt_pk_bf16(o[0], o[1]); w.y = cvt_pk_bf16(o[2], o[3]); *(u32x2*)(Aout + 4 * lane + 256 * j) = w; }
}
__device__ __forceinline__ void phase_final(const Args& a, int G, bool prompt_done) {
    if (prompt_done) {
        extern __shared__ __attribute__((aligned(16))) unsigned char lds_dyn_[]; float* red8 = (float*)lds_dyn_;
        const int tid_ = threadIdx.x, lane_ = tid_ & 63, wave_ = tid_ >> 6;
        for (int rs_ = blockIdx.x; rs_ < NS; rs_ += G) {
            const float* src = (const float*)(a.ws + WS_X2S) + (size_t)rs_ * DM + wave_ * 256 + 4 * lane_; const float* pp = (const float*)(a.ws + WS_P8) + (size_t)rs_ * DM + wave_ * 256 + 4 * lane_;
            f32x4 v = *(const f32x4*)src; f32x4 p[22];
#pragma unroll
            for (int k = 0; k < 22; ++k) p[k] = *(const f32x4*)(pp + (size_t)k * NS * DM);
#pragma unroll
            for (int k = 0; k < 22; ++k) v += p[k];
            const float ss = wave_sum((v[0] * v[0] + v[1] * v[1]) + (v[2] * v[2] + v[3] * v[3]));
            __syncthreads();
            if (lane_ == 0) red8[wave_] = ss;
            __syncthreads();
            const float tot = ((red8[0] + red8[1]) + (red8[2] + red8[3])) + ((red8[4] + red8[5]) + (red8[6] + red8[7]));
            const float rs = rsqrtf(tot * (1.f / DM) + EPS);
            *(f32x4*)(a.out + O_YS + (size_t)rs_ * DM + wave_ * 256 + 4 * lane_) = v * rs * *(const f32x4*)(a.in[I_GFIN] + wave_ * 256 + 4 * lane_);
        }
        return;
    }
    const int lane = threadIdx.x & 63, wave = threadIdx.x >> 6; const int gw = blockIdx.x * 8 + wave, NGW = G * 8;
    for (int r = prompt_done ? NP + gw : gw; r < MV; r += NGW) { float* p = r < NP ? a.out + O_YP + (size_t)r * DM : a.out + O_YS + (size_t)(r - NP) * DM;
        const float* src = r < NP ? p : (const float*)(a.ws + WS_X2S) + (size_t)(r - NP) * DM;
        f32x4 v[8]; float ss = 0.f;
#pragma unroll
        for (int j = 0; j < 8; ++j) { v[j] = *(const f32x4*)(src + 4 * lane + 256 * j);
            if (r >= NP) { for (int k = 0; k < 22; ++k) v[j] += *(const f32x4*)((const float*)(a.ws + WS_P8) + ((size_t)k * NS + (r - NP)) * DM + 4 * lane + 256 * j); } ss += (v[j][0] * v[j][0] + v[j][1] * v[j][1]) + (v[j][2] * v[j][2] + v[j][3] * v[j][3]); }
        ss = wave_sum(ss); const float rs = rsqrtf(ss * (1.f / DM) + EPS);
#pragma unroll
        for (int j = 0; j < 8; ++j) *(f32x4*)(p + 4 * lane + 256 * j) = v[j] * rs * *(const f32x4*)(a.in[I_GFIN] + 4 * lane + 256 * j); }
}

#define XB_TMO      128
#define XB_XCNT(j)  (256  + 64 * (j))
#define XB_XSUB(j)  (1280 + 64 * (j))
#define XB_XGEN(j)  (2304 + 64 * (j))
#define XB_TOP      3328
#define XB_TOPGEN   3392
#define XCD_BAR_WORDS 3456
#define XB_SPIN_CAP (1u << 18)
__device__ __forceinline__ unsigned xb_ld(unsigned* p)              { return __hip_atomic_load(p, __ATOMIC_RELAXED, __HIP_MEMORY_SCOPE_AGENT); }
__device__ __forceinline__ unsigned xb_add(unsigned* p, unsigned v) { return __hip_atomic_fetch_add(p, v, __ATOMIC_RELAXED, __HIP_MEMORY_SCOPE_AGENT); }
__device__ __forceinline__ unsigned xb_xcc_id() { return (unsigned)__builtin_amdgcn_s_getreg((3 << 11) | 20) & 0xFu; }
#define XB_SPIN(cond, bar) do { unsigned _sp = 0; while (cond) { __builtin_amdgcn_s_sleep(1); \
    if ((++_sp & 255u) == 0u) { if (xb_ld(&(bar)[XB_TMO])) break; if (_sp > XB_SPIN_CAP) { atomicAdd(&(bar)[XB_TMO], 1u); break; } } } } while (0)
struct XcdBarrier { unsigned* bar; unsigned x; volatile LAS unsigned* st; };
__device__ __forceinline__ void xcd_barrier_complete(unsigned* bar, unsigned x, unsigned& nloc, unsigned& nx) {
    const unsigned G = gridDim.x * gridDim.y * gridDim.z;
    unsigned sum, cnt, mine, sp = 0u;
    for (;;) {
        sum = 0u; cnt = 0u; mine = 0u;
#pragma unroll
        for (unsigned j = 0; j < 16; ++j) { const unsigned c = xb_ld(&bar[XB_XCNT(j)]); sum += c; cnt += (c > 0u) ? 1u : 0u; mine = (j == x) ? c : mine; }
        if (sum == G) break;
        __builtin_amdgcn_s_sleep(1);
        if ((++sp & 255u) == 0u) { if (xb_ld(&bar[XB_TMO])) break; if (sp > XB_SPIN_CAP) { atomicAdd(&bar[XB_TMO], 1u); break; } }
    }
    nloc = mine > 0u ? mine : 1u; nx = cnt > 0u ? cnt : 1u;
}
__device__ __forceinline__ void xcd_barrier(const XcdBarrier& b) {
    asm volatile("s_waitcnt vmcnt(0)" ::: "memory");
    __syncthreads();
    if (threadIdx.x == 0) {
        unsigned* bar = b.bar;
        __builtin_amdgcn_s_waitcnt(0);
        unsigned nloc = b.st[0], nx = b.st[1];
        if (nloc == 0u) { xcd_barrier_complete(bar, b.x, nloc, nx); b.st[0] = nloc; b.st[1] = nx; }
        const unsigned old = xb_add(&bar[XB_XSUB(b.x)], 1u);
        const unsigned gen = old / nloc;
        if (old + 1u == (gen + 1u) * nloc) {
            __builtin_amdgcn_fence(__ATOMIC_RELEASE, "agent");
            asm volatile("s_waitcnt vmcnt(0)" ::: "memory");
            const unsigned og = xb_add(&bar[XB_TOP], 1u);
            const unsigned tg = og / nx;
            if (og + 1u == (tg + 1u) * nx) xb_add(&bar[XB_TOPGEN], 1u);
            else XB_SPIN(xb_ld(&bar[XB_TOPGEN]) == tg, bar);
            __builtin_amdgcn_fence(__ATOMIC_ACQUIRE, "agent");
            xb_add(&bar[XB_XGEN(b.x)], 1u);
            asm volatile("s_waitcnt vmcnt(0)" ::: "memory");
        } else {
            XB_SPIN(xb_ld(&bar[XB_XGEN(b.x)]) == gen, bar);
            __builtin_amdgcn_fence(__ATOMIC_ACQUIRE, "agent");
            asm volatile("s_waitcnt vmcnt(0)" ::: "memory");
        }
    }
    __syncthreads();
}

__global__ void __launch_bounds__(512, 2) mk_fwd(Args a) {
    extern __shared__ __attribute__((aligned(16))) unsigned char lds[];
    cg::grid_group grid = cg::this_grid();
    LAS unsigned char* ring = (LAS unsigned char*)lds;
    const int G = gridDim.x, bx = blockIdx.x;
    unsigned char* ws = a.ws;
    const int lo = a.ph_lo, hi = a.ph_hi;
#define IN(k) (lo <= (k) && (k) < hi)
    XcdBarrier xbar; xbar.bar = (unsigned*)ws; xbar.x = xb_xcc_id(); xbar.st = (volatile LAS unsigned*)(ring + (LDS_BYTES - 64));
    if (threadIdx.x == 0) { xbar.st[0] = 0u; xbar.st[1] = 0u; if (hi - lo > 1) (void)xb_add(&xbar.bar[XB_XCNT(xbar.x)], 1u); }
    __syncthreads();
    if (hi > 4096) grid.sync();
#define SEAM(k) do { if (IN(k) && IN((k) + 1)) xcd_barrier(xbar); } while (0)
    const bf16_t* ABUF = (const bf16_t*)(ws + WS_ABUF);

    if (IN(0)) { phase_prologue(a, lds, G); }
    SEAM(0);
    if (IN(1)) {
        { pg8::SchedStd S; S.init(ws + WS_MN, ws + WS_WKV, DM, DM, 1024, 4096, G, bx);
          pg8::EpiKV E{a.out + O_PMK, a.out + O_PMV, (bf16_t*)(ws + WS_KB), (bf16_t*)(ws + WS_VT)};
          pg8::gemm_phase<pg8::EpiKV, pg8::SchedStd, true>(ring, DM, DM, DM, S, E); }
        { const int nwg1 = 4 * 16; pg8::SchedStd S; S.init(ABUF, ws + WS_WIN, DM, DM, MA, ZW, G, (bx + G - (nwg1 % G)) % G); pg8::EpiBf16 E{(bf16_t*)(ws + WS_Z), ZW};
          pg8::gemm_phase<pg8::EpiBf16, pg8::SchedStd, true>(ring, DM, DM, DM, S, E); }
        if (G == 256 && bx >= 212) { __syncthreads(); late_transposes(a, lds, 0, 32 * 88, (bx - 212) * 8 + (threadIdx.x >> 6), 352); }
    }
    SEAM(1);
    if (IN(2)) {
        for (int it = bx; it < 128; it += G) rg_item(a, lds, it >> 5, it & 7, (it >> 3) & 3);
        __syncthreads();
        for (int j = (bx + G - (128 % G)) % G; j < 128; j += G) ml_item(a, lds, j >> 5, (j >> 3) & 3, (j >> 1) & 3, j & 1);
        __syncthreads();
        for (int j = bx; j < NS; j += G) sample_item(a, lds, j);
        __syncthreads();
        if (G == 256) late_transposes(a, lds, 3 * 32 * 88, LATE_ITEMS, bx * 8 + (threadIdx.x >> 6), 2048);
        else late_transposes(a, lds, 0, LATE_ITEMS, bx * 8 + (threadIdx.x >> 6), G * 8);
    }
    SEAM(2);
    if (IN(3)) { phase_finalize(a, lds, G); }
    SEAM(3);
    if (IN(4)) {
        { pg8::SchedStd S; S.init(ws + WS_YMIX, ws + WS_WOUT, DM, DM, NP, DM, G, bx);
          pg8::EpiRes<1> E{a.in[I_XP], a.in[I_XS], (float*)(ws + WS_X1), nullptr, nullptr, a.in[I_GXA], (bf16_t*)(ws + WS_ABUF), (float*)(ws + WS_SSQ1)};
          pg8::gemm_phase<pg8::EpiRes<1>, pg8::SchedStd, true>(ring, DM, DM, DM, S, E); }
        { pg8::SchedSK S{(const char*)(ws + WS_YMIX) + (size_t)NP * DM * 2, (const char*)(ws + WS_WOUT), DM, 8, 8, G, bx}; pg8::EpiPartial E{(float*)(ws + WS_P3), DM};
          pg8::gemm_phase<pg8::EpiPartial, pg8::SchedSK, true>(ring, DM, DM, 256, S, E); }
    }
    SEAM(4);
    if (IN(5)) {
        { const int gw = bx * 8 + (threadIdx.x >> 6); if (gw < NS) sample_prep(a.in[I_XS] + (size_t)gw * DM, (const float*)(ws + WS_P3) + (size_t)gw * DM, 8, a.in[I_GXA], (bf16_t*)(ws + WS_ABUF) + (size_t)(NP + gw) * DM, (float*)(ws + WS_X1S) + (size_t)gw * DM, threadIdx.x & 63); }
        pg8::SchedStd S; S.init(ABUF, ws + WS_WQ, DM, DM, NP, DM, G, bx);
        pg8::EpiQ E{(const float*)(ws + WS_SSQ1), (bf16_t*)(ws + WS_QB), 0.04419417382415922f};
        pg8::gemm_phase<pg8::EpiQ, pg8::SchedStd, true>(ring, DM, DM, DM, S, E);
    }
    SEAM(5);
    if (IN(6)) {
        if (G >= 128) { pg8::SchedS S{(const char*)(ws + WS_QB), (const char*)(ws + WS_KB), G, bx}; pg8::EpiSoftmax E{(bf16_t*)(ws + WS_P)};
            pg8::gemm_phase<pg8::EpiSoftmax, pg8::SchedS, false>(ring, DM, DM, 512, S, E); }
        __syncthreads();
        { pg8::SchedSK S{(const char*)(ws + WS_ABUF) + (size_t)NP * DM * 2, (const char*)(ws + WS_WQ), DM, 8, 8, G, (bx + G - (128 % G)) % G}; pg8::EpiPartial E{(float*)(ws + WS_P4), DM};
          pg8::gemm_phase<pg8::EpiPartial, pg8::SchedSK, true>(ring, DM, DM, 256, S, E); }
        if (G == 256 && bx >= 192) { __syncthreads(); late_transposes(a, lds, 32 * 88, 2 * 32 * 88, (bx - 192) * 8 + (threadIdx.x >> 6), 512); }
    }
    SEAM(6);
    if (IN(7)) {
        { pg8::SchedPV S{(const char*)(ws + WS_P), (const char*)(ws + WS_VT), G, bx}; pg8::EpiBf16 E{(bf16_t*)(ws + WS_OB), DM};
          pg8::gemm_phase<pg8::EpiBf16, pg8::SchedPV, true>(ring, 256, 256, 256, S, E); }
        __syncthreads();
        for (int it = bx; it < NS * 4; it += G) sattn_item(a, lds, it >> 2, it & 3);
    }
    SEAM(7);
    if (IN(8)) {
        { pg8::SchedStd S; S.init(ws + WS_OB, ws + WS_WO, DM, DM, NP, DM, G, bx);
          pg8::EpiRes<2> E{nullptr, nullptr, (float*)(ws + WS_X1), nullptr, nullptr, a.in[I_GFFN], (bf16_t*)(ws + WS_ABUF), (float*)(ws + WS_SSQ2)};
          pg8::gemm_phase<pg8::EpiRes<2>, pg8::SchedStd, true>(ring, DM, DM, DM, S, E); }
        { pg8::SchedSK S{(const char*)(ws + WS_OB) + (size_t)NP * DM * 2, (const char*)(ws + WS_WO), DM, 8, 8, G, bx}; pg8::EpiPartial E{(float*)(ws + WS_P6), DM};
          pg8::gemm_phase<pg8::EpiPartial, pg8::SchedSK, true>(ring, DM, DM, 256, S, E); }
    }
    SEAM(8);
    if (IN(9)) {
        const int gw = bx * 8 + (threadIdx.x >> 6); if (gw < NS) sample_prep((const float*)(ws + WS_X1S) + (size_t)gw * DM, (const float*)(ws + WS_P6) + (size_t)gw * DM, 8, a.in[I_GFFN], (bf16_t*)(ws + WS_ABUF) + (size_t)(NP + gw) * DM, (float*)(ws + WS_X2S) + (size_t)gw * DM, threadIdx.x & 63);
    }
    SEAM(9);
    if (IN(10)) {
        { pg8::SchedStd S; S.init(ABUF, ws + WS_WGU, DM, DM, NP, 2 * DFF, G, bx);
          pg8::EpiGU E{(const float*)(ws + WS_SSQ2), (bf16_t*)(ws + WS_H)};
          pg8::gemm_phase<pg8::EpiGU, pg8::SchedStd, true>(ring, DM, DM, DM, S, E); }
        { const int nwg1 = (NP / 256) * (2 * DFF / 256); pg8::SchedStd S; S.init(ABUF + (size_t)NP * DM, ws + WS_WGU, DM, DM, 256, 2 * DFF, G, (bx + G - (nwg1 % G)) % G);
          pg8::EpiGU E{nullptr, (bf16_t*)(ws + WS_H) + (size_t)NP * DFF};
          pg8::gemm_phase<pg8::EpiGU, pg8::SchedStd, true>(ring, DM, DM, DM, S, E); }
        if (G == 256 && bx >= 172) { __syncthreads(); late_transposes(a, lds, 2 * 32 * 88, 3 * 32 * 88, (bx - 172) * 8 + (threadIdx.x >> 6), 672); }
    }
    SEAM(10);
    if (IN(11)) {
        if (G == 256) { pg8::SchedStd S; S.init(ws + WS_H, ws + WS_WD, DFF, DFF, NP, DM, G, bx);
          pg8::EpiFinal E{(const float*)(ws + WS_X1), a.out + O_YP, a.in[I_GFIN], (float*)(ws + WS_SLOTS), (unsigned*)ws + 4096};
          pg8::gemm_phase<pg8::EpiFinal, pg8::SchedStd, false>(ring, DFF, DFF, DFF, S, E); }
        else { pg8::SchedStd S; S.init(ws + WS_H, ws + WS_WD, DFF, DFF, NP, DM, G, bx);
          pg8::EpiRes<3> E{nullptr, nullptr, (float*)(ws + WS_X1), a.out + O_YP, a.out + O_YS, nullptr, nullptr, nullptr};
          pg8::gemm_phase<pg8::EpiRes<3>, pg8::SchedStd, true>(ring, DFF, DFF, DFF, S, E); }
        { pg8::SchedSK S{(const char*)(ws + WS_H) + (size_t)NP * DFF * 2, (const char*)(ws + WS_WD), DFF, 8, 22, G, bx}; pg8::EpiPartial E{(float*)(ws + WS_P8), DM};
          pg8::gemm_phase<pg8::EpiPartial, pg8::SchedSK, true>(ring, DFF, DFF, 256, S, E); }
    }
    SEAM(11);
    if (IN(12)) { phase_final(a, G, G == 256); }
#undef IN
#undef SEAM
}

extern "C" void kernel_launch(void* const* d_in, const int* in_sizes, int n_in, void* d_out, int out_size, void* d_ws, size_t ws_size, hipStream_t stream) {
    static int grid = 0;
    if (grid == 0) {
        if (n_in != 35 || (size_t)out_size != O_END || ws_size < WS_END) { fprintf(stderr, "kernel_launch: unexpected sizes n_in %d out %d ws %zu\n", n_in, out_size, ws_size); grid = -1; return; }
        int dev = 0, cus = 0, per_cu = 0;
        (void)hipGetDevice(&dev); (void)hipDeviceGetAttribute(&cus, hipDeviceAttributeMultiprocessorCount, dev);
        if (hipFuncSetAttribute((const void*)mk_fwd, hipFuncAttributeMaxDynamicSharedMemorySize, LDS_BYTES) != hipSuccess) { fprintf(stderr, "kernel_launch: hipFuncSetAttribute failed\n"); grid = -1; return; }
        if (hipOccupancyMaxActiveBlocksPerMultiprocessor(&per_cu, (const void*)mk_fwd, 512, LDS_BYTES) != hipSuccess || per_cu < 1) { fprintf(stderr, "kernel_launch: occupancy query says %d\n", per_cu); per_cu = 1; }
        (void)hipGetLastError();
        grid = cus * 1;
        if (grid < 128) fprintf(stderr, "kernel_launch: grid %d < 128\n", grid);
    }
    if (grid < 0) return;
    Args a{};
    for (int i = 0; i < 35; ++i) a.in[i] = (const float*)d_in[i];
    a.out = (float*)d_out; a.ws = (unsigned char*)d_ws;
    constexpr int NL = MK_N_LAUNCHES;
    if (hipMemsetAsync(d_ws, 0, 32768, stream) != hipSuccess) { fprintf(stderr, "kernel_launch: memset of the barrier word failed\n"); return; }
    for (int li = 0; li < NL; ++li) {
        a.ph_lo = (NL == 1) ? 0 : li; a.ph_hi = (NL == 1) ? N_PHASES : li + 1;
        void* args[] = {&a};
        hipError_t e = hipLaunchCooperativeKernel((const void*)mk_fwd, dim3(grid), dim3(512), args, LDS_BYTES, stream);
        if (e != hipSuccess) { fprintf(stderr, "kernel_launch: cooperative launch %d failed: %s (grid %d)\n", li, hipGetErrorString(e), grid); break; }
    }
}
```
